# Optimizing an MI355X kernel written in HIP

```python
import math
import jax, jax.numpy as jnp
from jax import lax
import numpy as np

D_MODEL = 2048
BATCH = 4
SEQ = 4096
DEPTH = 4

MIX_WIDTH = D_MODEL
HG_WIDTH = MIX_WIDTH // 2
DA_WIDTH = MIX_WIDTH - HG_WIDTH
HG_HEADS = 8
HG_DK = HG_WIDTH // HG_HEADS
HG_DV = HG_WIDTH // HG_HEADS
HG_CHUNK = 64
DA_HEADS = 8
DA_DV = DA_WIDTH // DA_HEADS
DA_DH = DA_DV // 2
Q_BLOCK = 128
D_FF = -(-8 * D_MODEL // (3 * 256)) * 256
EPS = 1e-6
LB_FLOOR = 1e-30
LB_CEIL = 1.0 - 1e-6
SPLIT_WIDTHS = [HG_WIDTH] * 5 + [DA_WIDTH] * 3
W_IN_COLS = sum(SPLIT_WIDTHS)

kernel_name = 'hybrid_hgrn2_diffattn_encoder'


def rmsnorm(x, w):
    xf = x.astype(jnp.float32)
    var = jnp.mean(xf * xf, axis=-1, keepdims=True)
    return (xf * lax.rsqrt(var + EPS)).astype(x.dtype) * w


def alibi_slopes(n):
    return jnp.asarray([2.0 ** (-8.0 * (i + 1) / n) for i in range(n)], dtype=jnp.float32)


def log_forget(z, lb):
    lb = jnp.clip(lb, 0.0, LB_CEIL)
    return jnp.logaddexp(jnp.log(jnp.maximum(lb, LB_FLOOR)),
                         jnp.log1p(-lb) + jax.nn.log_sigmoid(z))


def gla_chunk_scan(q, k, v, log_f):
    b, h, s, dk = q.shape
    dv = v.shape[-1]
    nc = s // HG_CHUNK

    def to_chunks(t):
        return jnp.moveaxis(t.reshape(b, h, nc, HG_CHUNK, t.shape[-1]), 2, 0)

    tri = jnp.tril(jnp.ones((HG_CHUNK, HG_CHUNK), dtype=bool))[:, :, None]

    def step(state, inp):
        qc, kc, vc, gc = inp
        a = jnp.cumsum(gc, axis=2)
        o_inter = jnp.einsum('bhtd,bhde->bhte', qc * jnp.exp(a), state)
        diff = a[:, :, :, None, :] - a[:, :, None, :, :]
        decay = jnp.where(tri, jnp.exp(jnp.minimum(diff, 0.0)), 0.0)
        scores = jnp.einsum('bhtd,bhsd,bhtsd->bhts', qc, kc, decay)
        o_intra = jnp.einsum('bhts,bhse->bhte', scores, vc)
        a_last = a[:, :, -1:, :]
        state = (jnp.exp(a_last)[:, :, 0, :, None] * state
                 + jnp.einsum('bhsd,bhse->bhde', kc * jnp.exp(a_last - a), vc))
        return state, o_inter + o_intra

    init = jnp.zeros((b, h, dk, dv), dtype=q.dtype)
    _, o = lax.scan(step, init, (to_chunks(q), to_chunks(k), to_chunks(v), to_chunks(log_f)))
    return jnp.moveaxis(o, 0, 2).reshape(b, h, s, dv)


def hgrn2_mixer(q, zf_fwd, zf_bwd, v, g, lb_fwd, lb_bwd, onorm_w):
    bsz, slen = q.shape[0], q.shape[1]

    def heads(t):
        return jnp.transpose(t.reshape(bsz, slen, HG_HEADS, -1).astype(jnp.float32), (0, 2, 1, 3))

    qh, vh = heads(q), heads(v)

    def one_direction(zf, lb, flip):
        lf = log_forget(heads(zf), lb.reshape(HG_HEADS, 1, HG_DK))
        kh = -jnp.expm1(lf)
        args = (qh, kh, vh, lf)
        if flip:
            args = tuple(jnp.flip(t, axis=2) for t in args)
        o = gla_chunk_scan(*args)
        return jnp.flip(o, axis=2) if flip else o

    o = one_direction(zf_fwd, lb_fwd, False) + one_direction(zf_bwd, lb_bwd, True)
    o = jnp.transpose(o, (0, 2, 1, 3))
    o = rmsnorm(o, onorm_w) * jax.nn.silu(g.reshape(o.shape).astype(jnp.float32))
    return o.reshape(bsz, slen, HG_WIDTH)


def diff_attention(q, k, v, qn_w, kn_w, lam, lam_init, subln_w):
    bsz, slen = q.shape[0], q.shape[1]
    q = rmsnorm(q.reshape(bsz, slen, DA_HEADS, 2, DA_DH), qn_w) * (DA_DH ** -0.5)
    k = rmsnorm(k.reshape(bsz, slen, DA_HEADS, 2, DA_DH), kn_w)
    v = v.reshape(bsz, slen, DA_HEADS, DA_DV)
    slopes = alibi_slopes(DA_HEADS)
    nb = slen // Q_BLOCK
    q_blocks = jnp.moveaxis(q.reshape(bsz, nb, Q_BLOCK, DA_HEADS, 2, DA_DH), 1, 0)
    starts = jnp.arange(nb, dtype=jnp.int32) * Q_BLOCK
    pos_k = jnp.arange(slen, dtype=jnp.int32)

    def block(args):
        q_blk, start = args
        s = jnp.einsum('bthmd,bshmd->bhmts', q_blk, k).astype(jnp.float32)
        pos_q = start + jnp.arange(Q_BLOCK, dtype=jnp.int32)
        dist = jnp.abs(pos_q[:, None] - pos_k[None, :]).astype(jnp.float32)
        s = s - slopes[None, :, None, None, None] * dist
        p = jax.nn.softmax(s, axis=-1)
        attn = p[:, :, 0] - lam * p[:, :, 1]
        return jnp.einsum('bhts,bshe->bthe', attn.astype(v.dtype), v)

    o = lax.map(block, (q_blocks, starts))
    o = jnp.moveaxis(o, 0, 1).reshape(bsz, slen, DA_HEADS, DA_DV)
    o = rmsnorm(o, subln_w) * (1.0 - lam_init)
    return o.reshape(bsz, slen, DA_WIDTH)


def setup_inputs(seed: int = 0) -> dict:
    key = jax.random.key(seed)
    ks = jax.random.split(key, 16)
    f32 = jnp.float32

    def nrm(k, shape, scale):
        return jax.random.normal(k, shape, dtype=f32) * scale

    return {
        'x': nrm(ks[0], (BATCH, SEQ, D_MODEL), 1.0),
        'norm_mix_w': 1.0 + nrm(ks[1], (DEPTH, D_MODEL), 0.02),
        'w_in': nrm(ks[2], (DEPTH, D_MODEL, W_IN_COLS), D_MODEL ** -0.5),
        'hg_lb_logits': 1.0 + nrm(ks[3], (2, DEPTH, HG_WIDTH), 0.1),
        'hg_onorm_w': 1.0 + nrm(ks[4], (DEPTH, HG_DV), 0.02),
        'da_qnorm_w': 1.0 + nrm(ks[5], (DEPTH, DA_DH), 0.02),
        'da_knorm_w': 1.0 + nrm(ks[6], (DEPTH, DA_DH), 0.02),
        'da_lambda': nrm(ks[7], (DEPTH, 4, DA_DH), 0.1),
        'da_subln_w': 1.0 + nrm(ks[8], (DEPTH, DA_DV), 0.02),
        'w_out': nrm(ks[9], (DEPTH, MIX_WIDTH, D_MODEL), MIX_WIDTH ** -0.5),
        'norm_ffn_w': 1.0 + nrm(ks[10], (DEPTH, D_MODEL), 0.02),
        'w_gate': nrm(ks[11], (DEPTH, D_MODEL, D_FF), D_MODEL ** -0.5),
        'w_up': nrm(ks[12], (DEPTH, D_MODEL, D_FF), D_MODEL ** -0.5),
        'w_down': nrm(ks[13], (DEPTH, D_FF, D_MODEL), D_FF ** -0.5),
    }


def reference(x, norm_mix_w, w_in, hg_lb_logits, hg_onorm_w, da_qnorm_w, da_knorm_w,
              da_lambda, da_subln_w, w_out, norm_ffn_w, w_gate, w_up, w_down):
    p_lb = jax.nn.softmax(hg_lb_logits.astype(jnp.float32), axis=1)
    lower_bounds = jnp.cumsum(p_lb, axis=1) - p_lb[:, :1]
    split_idx = list(np.cumsum(SPLIT_WIDTHS)[:-1].tolist())

    for l in range(DEPTH):
        h = rmsnorm(x, norm_mix_w[l])
        proj = jnp.einsum('bsd,dc->bsc', h, w_in[l])
        hq, hf_f, hf_b, hi, hg, dq, dk, dv = jnp.split(proj, split_idx, axis=-1)

        o_hg = hgrn2_mixer(hq, hf_f, hf_b, hi, hg,
                           lower_bounds[0, l], lower_bounds[1, l], hg_onorm_w[l])

        lam_p = da_lambda[l].astype(jnp.float32)
        lam_init = 0.8 - 0.6 * math.exp(-0.3 * l)
        lam = (jnp.exp(jnp.sum(lam_p[0] * lam_p[1])) - jnp.exp(jnp.sum(lam_p[2] * lam_p[3]))
               + lam_init)
        o_da = diff_attention(dq, dk, dv, da_qnorm_w[l], da_knorm_w[l], lam, lam_init,
                              da_subln_w[l])

        mixed = jnp.concatenate([o_hg.astype(x.dtype), o_da.astype(x.dtype)], axis=-1)
        x = x + jnp.einsum('bsc,cd->bsd', mixed, w_out[l])

        h = rmsnorm(x, norm_ffn_w[l])
        u = jax.nn.silu(jnp.einsum('bsd,df->bsf', h, w_gate[l])) * jnp.einsum('bsd,df->bsf', h, w_up[l])
        x = x + jnp.einsum('bsf,fd->bsd', u, w_down[l])
    return x
```

```cpp
#include <hip/hip_runtime.h>
#include <hip/hip_cooperative_groups.h>
#include <cstdio>
#include <cstdint>
namespace cg = cooperative_groups;
namespace pg8 {
#define PG8_LAS __attribute__((address_space(3)))
typedef unsigned short bf16_t;
typedef short bf16x8 __attribute__((ext_vector_type(8)));
typedef float f32x4 __attribute__((ext_vector_type(4)));
typedef unsigned u32x4 __attribute__((ext_vector_type(4)));
constexpr int BM = 256, BK = 64, HALF = 128, HTB = HALF * BK * 2  , STAGE_BYTES = 8 * HTB, NXCD = 8, WGM = 8;

__host__ __device__ __forceinline__ int lds_byte(int r, int c) { const int st = (r >> 4) * 2 + (c >> 5), rr = r & 15, cc = c & 31, ob = rr * 64 + cc * 2; return st * 1024 + (ob ^ (((ob >> 9) & 1) << 5)); }
__host__ __device__ __forceinline__ void stage_rc(int b, int& R, int& C) { const int st = b / 1024, sb = b % 1024, swz = sb ^ (((sb >> 9) & 1) << 5); R = (st >> 1) * 16 + swz / 64; C = (st & 1) * 32 + (swz % 64) / 2; }
__host__ __device__ __forceinline__ int perm32(int rho) { const int n = rho >> 4, i = rho & 15; return 8 * (i >> 2) + 4 * n + (i & 3); }

struct Unit { int pm, pn; };
struct Gemm { const bf16_t* A; const bf16_t* Bt; int M, N, K; };

struct StaticOrder {
    int nM, nN, nwg, G, c;
    __host__ __device__ void init(int M, int N, int G_, int c_) { nM = M / BM; nN = N / BM; nwg = nM * nN; G = G_; c = c_; }
    __host__ __device__ bool next(int i, Unit& u) const {
        const long L = (long)i * G + c; if (L >= nwg) return false;
        int wgid = (int)L; { const int q = nwg / NXCD, r = nwg % NXCD, xcd = wgid % NXCD, off = wgid / NXCD; wgid = (xcd < r ? xcd * (q + 1) : r * (q + 1) + (xcd - r) * q) + off; }
        const int nig = WGM * nN, gid = wgid / nig, fm = gid * WGM, gsz = (nM - fm) < WGM ? (nM - fm) : WGM;
        u.pm = fm + ((wgid % nig) % gsz); u.pn = (wgid % nig) / gsz; return true;
    }
    __device__ __forceinline__ void a_ready(const Unit&) const {}
    __device__ __forceinline__ void done(const Unit&) const {}
};

__device__ __forceinline__ unsigned cvt_pk_bf16(float lo, float hi) { unsigned r; asm volatile("v_cvt_pk_bf16_f32 %0, %1, %2" : "=v"(r) : "v"(lo), "v"(hi)); return r; }
typedef float f32x2 __attribute__((ext_vector_type(2)));
__device__ __forceinline__ f32x2 gelu_pk(f32x2 v) {
    const f32x2 av = __builtin_elementwise_abs(v), d = av * 0.2316418882f + 1.0f;
    f32x2 t; t.x = __builtin_amdgcn_rcpf(d.x); t.y = __builtin_amdgcn_rcpf(d.y);
    f32x2 q = t * 0.5307027145f + (-0.7265760135f); q = q * t + 0.7107068705f; q = q * t + (-0.142248368f); q = q * t + 0.127414796f; q = q * t;
    const f32x2 s = (v * v) * (-0.72134752044f);
    f32x2 e; e.x = __builtin_amdgcn_exp2f(s.x); e.y = __builtin_amdgcn_exp2f(s.y);
    const f32x2 m = v * (q * e), r = v - m;
    f32x2 o; o.x = v.x < 0.f ? m.x : r.x; o.y = v.y < 0.f ? m.y : r.y; return o;
}

template <int ACT  > struct EpiBf16 {
    static constexpr bool PERM = true, AFTER_DRAIN = false; static_assert(ACT == 0 || ACT == 1, "EpiBf16: ACT is 0 (none) or 1 (gelu_pk)");
    bf16_t* O; int ldc; const float* bias; int split_cols; size_t split_stride; float scale0;
    __device__ __forceinline__ void operator()(const f32x4 (&acc)[2][2][4][2], const Unit& u, int wr, int wc, int fr, int fq) const {
        const int row0 = u.pm * BM + wr * 64 + fr; int colt = u.pn * BM; bf16_t* base = O;
        float sc = 1.f; if (split_cols) { const int t = colt / split_cols; base += (size_t)t * split_stride; colt -= t * split_cols; if (t == 0) sc = scale0; }
        const int col0 = colt + wc * 32 + 8 * fq, bcol0 = u.pn * BM + wc * 32 + 8 * fq;
        f32x4 bv[2][2];
#pragma unroll
        for (int bj = 0; bj < 2; ++bj)
#pragma unroll
            for (int n = 0; n < 2; ++n) bv[bj][n] = bias ? *(const f32x4*)(bias + bcol0 + bj * HALF + 4 * n) : (f32x4){0.f, 0.f, 0.f, 0.f};
#pragma unroll
        for (int ai = 0; ai < 2; ++ai)
#pragma unroll
            for (int m = 0; m < 4; ++m) { bf16_t* rowp = base + (size_t)(row0 + ai * HALF + m * 16) * ldc + col0;
#pragma unroll
                for (int bj = 0; bj < 2; ++bj) { f32x4 v0 = acc[ai][bj][m][0] + bv[bj][0], v1 = acc[ai][bj][m][1] + bv[bj][1];
                    if (ACT == 1) { f32x2 a = gelu_pk((f32x2){v0[0], v0[1]}), b = gelu_pk((f32x2){v0[2], v0[3]}), c = gelu_pk((f32x2){v1[0], v1[1]}), d = gelu_pk((f32x2){v1[2], v1[3]});
                        v0 = (f32x4){a.x, a.y, b.x, b.y}; v1 = (f32x4){c.x, c.y, d.x, d.y}; }
                    v0 = v0 * sc; v1 = v1 * sc; u32x4 w; w.x = cvt_pk_bf16(v0[0], v0[1]); w.y = cvt_pk_bf16(v0[2], v0[3]); w.z = cvt_pk_bf16(v1[0], v1[1]); w.w = cvt_pk_bf16(v1[2], v1[3]);
                    *(u32x4*)(rowp + bj * HALF) = w; } }
    }
};

struct PanelStats {
    unsigned* xbuf;
    unsigned* cnt;
    unsigned* tmo;
    int ntn; float eps;
    unsigned code;
    __device__ __forceinline__ bool run(const f32x4 (&v)[2][2][4][2], const Unit& u, int wr, int wc, int fr, int fq, PG8_LAS unsigned char* lds, int wid, int lane) const {
        typedef float f32x2v __attribute__((ext_vector_type(2)));
        PG8_LAS f32x2v* P = (PG8_LAS f32x2v*)lds;
        PG8_LAS f32x2v* S = (PG8_LAS f32x2v*)(lds + 8192);
        PG8_LAS unsigned* flag = (PG8_LAS unsigned*)(lds + 8192 + 2048);
#pragma unroll
        for (int ai = 0; ai < 2; ++ai)
#pragma unroll
            for (int m = 0; m < 4; ++m) {
                float s = 0.f;
#pragma unroll
                for (int bj = 0; bj < 2; ++bj)
#pragma unroll
                    for (int n = 0; n < 2; ++n) { const f32x4 x = v[ai][bj][m][n]; s += (x[0] + x[1]) + (x[2] + x[3]); }
                s += __shfl_xor(s, 16); s += __shfl_xor(s, 32);
                const float mw = s * (1.0f / 64.0f); float q = 0.f;
#pragma unroll
                for (int bj = 0; bj < 2; ++bj)
#pragma unroll
                    for (int n = 0; n < 2; ++n) { const f32x4 d = v[ai][bj][m][n] - mw; q += (d[0] * d[0] + d[1] * d[1]) + (d[2] * d[2] + d[3] * d[3]); }
                q += __shfl_xor(q, 16); q += __shfl_xor(q, 32);
                if (fq == 0) P[(ai * HALF + wr * 64 + m * 16 + fr) * 4 + wc] = (f32x2v){mw, q};
            }
        asm volatile("s_waitcnt lgkmcnt(0)" ::: "memory"); __builtin_amdgcn_s_barrier(); asm volatile("" ::: "memory");
#if defined(BROKEN_EXCHANGE_NO_WAIT)
#warning BROKEN CONTROL BUILD: the row-statistics exchange does not wait; results are wrong by design
        if (blockIdx.x >= 64) { const long long t0_ = clock64(); while (clock64() - t0_ < 60000) __builtin_amdgcn_s_sleep(8); }
#endif
        const int row = wid * 32 + (lane & 31);
        if (lane < 32) {
            const f32x2v a = P[row * 4 + 0], b = P[row * 4 + 1], c = P[row * 4 + 2], d = P[row * 4 + 3];
            const float mt = (a.x + b.x + c.x + d.x) * 0.25f;
            const float da = a.x - mt, db = b.x - mt, dc = c.x - mt, dd = d.x - mt;
            const float m2 = (a.y + b.y) + (c.y + d.y) + 64.0f * ((da * da + db * db) + (dc * dc + dd * dd));
            unsigned long long* slot = (unsigned long long*)xbuf + ((size_t)(u.pm * BM + row) * 4 + u.pn);
            __hip_atomic_store(slot, ((unsigned long long)__float_as_uint(m2) << 32) | __float_as_uint(mt), __ATOMIC_RELAXED, __HIP_MEMORY_SCOPE_AGENT);
        }
        asm volatile("s_waitcnt vmcnt(0)" ::: "memory");
        if (lane == 0) __hip_atomic_fetch_add(cnt + 64 * u.pm, 1u, __ATOMIC_RELAXED, __HIP_MEMORY_SCOPE_AGENT);
        if (wid == 0) {
            bool dead = false; const unsigned long long t0 = __builtin_amdgcn_s_memrealtime(); const unsigned want = 8u * (unsigned)ntn;
            for (;;) {
#if defined(BROKEN_EXCHANGE_NO_WAIT)
                break;
#endif
                if ((unsigned)__builtin_amdgcn_readfirstlane(__hip_atomic_load(cnt + 64 * u.pm, __ATOMIC_RELAXED, __HIP_MEMORY_SCOPE_AGENT)) >= want) break;
                if (__builtin_amdgcn_s_memrealtime() - t0 > 2000000ull) {
                    if (lane == 0) { unsigned expect = 0u; __hip_atomic_compare_exchange_strong(tmo + 1, &expect, code | (unsigned)(u.pm & 0xff), __ATOMIC_RELAXED, __ATOMIC_RELAXED, __HIP_MEMORY_SCOPE_AGENT);
                                     __hip_atomic_store(tmo, 1u, __ATOMIC_RELAXED, __HIP_MEMORY_SCOPE_AGENT); }
                    dead = true; break; }
                __builtin_amdgcn_s_sleep(2);
            }
            __builtin_amdgcn_fence(__ATOMIC_ACQUIRE, "agent");
            if (lane == 0) flag[0] = dead ? 1u : 0u;
        }
        asm volatile("s_waitcnt vmcnt(0) lgkmcnt(0)" ::: "memory"); __builtin_amdgcn_s_barrier(); asm volatile("" ::: "memory");
        const bool bad = flag[0] != 0u;
        if (lane < 32) {
            const unsigned long long* slot = (const unsigned long long*)xbuf + (size_t)(u.pm * BM + row) * 4; float mt[4], m2[4]; float ms = 0.f;
#pragma unroll
            for (int t = 0; t < 4; ++t) { if (t < ntn) { const unsigned long long w = __hip_atomic_load(slot + t, __ATOMIC_RELAXED, __HIP_MEMORY_SCOPE_AGENT); mt[t] = __uint_as_float((unsigned)w); m2[t] = __uint_as_float((unsigned)(w >> 32)); } else { mt[t] = 0.f; m2[t] = 0.f; } ms += mt[t]; }
            const float mean = ms / (float)ntn; float q = 0.f;
#pragma unroll
            for (int t = 0; t < 4; ++t) if (t < ntn) { const float dm = mt[t] - mean; q += m2[t] + 256.0f * dm * dm; }
            S[row] = (f32x2v){mean, 1.0f / sqrtf(q / (256.0f * (float)ntn) + eps)};
        }
        asm volatile("s_waitcnt lgkmcnt(0)" ::: "memory"); __builtin_amdgcn_s_barrier(); asm volatile("" ::: "memory");
        return bad;
    }
};
struct EpiLnRes {
    static constexpr bool PERM = false, AFTER_DRAIN = true;
    const float* base; float* out; int ldc; const float* bias; PanelStats st; unsigned poison;
    __device__ __forceinline__ void fused(f32x4 (&acc)[2][2][4][2], const Unit& u, int wr, int wc, int fr, int fq, PG8_LAS unsigned char* lds, int wid, int lane) const {
        typedef float f32x2v __attribute__((ext_vector_type(2)));
        const PG8_LAS f32x2v* S = (const PG8_LAS f32x2v*)(lds + 8192);
        const int col0 = u.pn * BM + wc * 32 + 4 * fq;
#pragma unroll
        for (int bj = 0; bj < 2; ++bj)
#pragma unroll
            for (int n = 0; n < 2; ++n) { const f32x4 bv = bias ? *(const f32x4*)(bias + col0 + bj * HALF + n * 16) : (f32x4){0.f, 0.f, 0.f, 0.f};
#pragma unroll
                for (int ai = 0; ai < 2; ++ai)
#pragma unroll
                    for (int m = 0; m < 4; ++m) acc[ai][bj][m][n] += bv; }
        f32x4 pre[4][2][2];
#pragma unroll
        for (int m = 0; m < 4; ++m) { const size_t off = (size_t)(u.pm * BM + wr * 64 + m * 16 + fr) * ldc + col0;
#pragma unroll
            for (int bj = 0; bj < 2; ++bj)
#pragma unroll
                for (int n = 0; n < 2; ++n) pre[m][bj][n] = *(const f32x4*)(base + off + bj * HALF + n * 16); }
        const bool bad = st.run(acc, u, wr, wc, fr, fq, lds, wid, lane) || poison != 0u;
        const float qnan = __builtin_nanf("");
#pragma unroll
        for (int ai = 0; ai < 2; ++ai)
#pragma unroll
            for (int m = 0; m < 4; ++m) { const int r = ai * HALF + wr * 64 + m * 16 + fr; const f32x2v sr = S[r]; const size_t off = (size_t)(u.pm * BM + r) * ldc + col0;
#pragma unroll
                for (int bj = 0; bj < 2; ++bj)
#pragma unroll
                    for (int n = 0; n < 2; ++n) { const f32x4 bs = ai == 0 ? pre[m][bj][n] : *(const f32x4*)(base + off + bj * HALF + n * 16); f32x4 o = bs + (acc[ai][bj][m][n] - sr.x) * sr.y;
                        if (bad) o = (f32x4){qnan, qnan, qnan, qnan}; *(f32x4*)(out + off + bj * HALF + n * 16) = o; }
                if (m & 1) asm volatile("" ::: "memory"); }
    }
};
struct EpiLnResLn {
    static constexpr bool PERM = false, AFTER_DRAIN = true;
    const float* base; float* out; bf16_t* xn; int ldc; const float* bias; PanelStats st1, st2; unsigned poison;
    __device__ __forceinline__ void fused(f32x4 (&acc)[2][2][4][2], const Unit& u, int wr, int wc, int fr, int fq, PG8_LAS unsigned char* lds, int wid, int lane) const {
        typedef float f32x2v __attribute__((ext_vector_type(2))); typedef unsigned u32x2v __attribute__((ext_vector_type(2)));
        const PG8_LAS f32x2v* S = (const PG8_LAS f32x2v*)(lds + 8192);
        const int col0 = u.pn * BM + wc * 32 + 4 * fq;
#pragma unroll
        for (int bj = 0; bj < 2; ++bj)
#pragma unroll
            for (int n = 0; n < 2; ++n) { const f32x4 bv = bias ? *(const f32x4*)(bias + col0 + bj * HALF + n * 16) : (f32x4){0.f, 0.f, 0.f, 0.f};
#pragma unroll
                for (int ai = 0; ai < 2; ++ai)
#pragma unroll
                    for (int m = 0; m < 4; ++m) acc[ai][bj][m][n] += bv; }
        bool bad = st1.run(acc, u, wr, wc, fr, fq, lds, wid, lane) || poison != 0u;
        const float qnan = __builtin_nanf("");
#pragma unroll
        for (int ai = 0; ai < 2; ++ai)
#pragma unroll
            for (int m = 0; m < 4; ++m) { const int r = ai * HALF + wr * 64 + m * 16 + fr; const f32x2v sr = S[r]; const size_t off = (size_t)(u.pm * BM + r) * ldc + col0;
#pragma unroll
                for (int bj = 0; bj < 2; ++bj)
#pragma unroll
                    for (int n = 0; n < 2; ++n) { const f32x4 bs = *(const f32x4*)(base + off + bj * HALF + n * 16); acc[ai][bj][m][n] = bs + (acc[ai][bj][m][n] - sr.x) * sr.y; }
                asm volatile("" : "+v"(acc[ai][0][m][0]), "+v"(acc[ai][0][m][1]), "+v"(acc[ai][1][m][0]), "+v"(acc[ai][1][m][1]));
                if (m & 1) asm volatile("" ::: "memory"); }
        const bool bad1 = bad;
        bad = st2.run(acc, u, wr, wc, fr, fq, lds, wid, lane) || bad;
#pragma unroll
        for (int ai = 0; ai < 2; ++ai)
#pragma unroll
            for (int m = 0; m < 4; ++m) { const int r = ai * HALF + wr * 64 + m * 16 + fr; const f32x2v sr = S[r]; const size_t off = (size_t)(u.pm * BM + r) * ldc + col0;
#pragma unroll
                for (int bj = 0; bj < 2; ++bj)
#pragma unroll
                    for (int n = 0; n < 2; ++n) { const f32x4 x1 = acc[ai][bj][m][n]; *(f32x4*)(out + off + bj * HALF + n * 16) = bad1 ? (f32x4){qnan, qnan, qnan, qnan} : x1;
                        const f32x4 o = (x1 - sr.x) * sr.y; u32x2v w; w.x = cvt_pk_bf16(o[0], o[1]); w.y = cvt_pk_bf16(o[2], o[3]);
                        if (bad) { w.x = 0x7fc07fc0u; w.y = 0x7fc07fc0u; } *(u32x2v*)(xn + off + bj * HALF + n * 16) = w; }
                asm volatile("" ::: "memory"); }
    }
};

template <class Epi, class Sched, bool ALIGN_EPI = false, bool SP2 = false>
__device__ __forceinline__ void gemm_phase(PG8_LAS unsigned char* lds, const Gemm g, const Sched& S, const Epi& E) {
    int tid_o = threadIdx.x; asm volatile("" : "+v"(tid_o));
    const int tid = tid_o, wid = __builtin_amdgcn_readfirstlane(tid >> 6), lane = tid & 63, wr = wid >> 2, wc = wid & 3, fr = lane & 15, fq = lane >> 4;
    const int K = g.K, nt = K / BK;
    unsigned voffA[2], voffB[2];
#pragma unroll
    for (int i = 0; i < 2; ++i) { int R, C; stage_rc(tid * 16 + i * 8192, R, C); const int Rb = Epi::PERM ? ((R & ~31) + perm32(R & 31)) : R;
        voffA[i] = (unsigned)(R * K + C) * 2u; voffB[i] = (unsigned)(Rb * K + C) * 2u; }
    const size_t kstep = (size_t)(BK * 2);
    const size_t hstep = (size_t)HALF * K * 2;
    const size_t tstep = 2 * hstep;
    const unsigned ldsw = (unsigned)wid * 1024u;
    const int aoff = lds_byte(wr * 64 + fr, fq * 8), boff = lds_byte(wc * 32 + fr, fq * 8);
#define PG8_SA(b, h) (((b) * 2 + (h)) * HTB)
#define PG8_SB(b, h) ((4 + (b) * 2 + (h)) * HTB)
#define PG8_STAGE(bufoff, gbase, voff) do { _Pragma("unroll") for (int _i = 0; _i < 2; ++_i) \
        __builtin_amdgcn_global_load_lds((const unsigned*)((const char*)(gbase) + (voff)[_i]), (PG8_LAS unsigned*)(lds + (bufoff) + ldsw + _i * 8192), 16, 0, 0); } while (0)
#define PG8_LDA(dst, b, h) do { _Pragma("unroll") for (int m = 0; m < 4; ++m) _Pragma("unroll") for (int k = 0; k < 2; ++k) dst[m][k] = *(const PG8_LAS bf16x8*)(lds + PG8_SA(b, h) + aoff + m * 2048 + k * 1024); } while (0)
#define PG8_LDB(dst, b, h) do { _Pragma("unroll") for (int n = 0; n < 2; ++n) _Pragma("unroll") for (int k = 0; k < 2; ++k) dst[n][k] = *(const PG8_LAS bf16x8*)(lds + PG8_SB(b, h) + boff + n * 2048 + k * 1024); } while (0)
#define PG8_MMA(ai, bj, At, Bt) do { __builtin_amdgcn_s_setprio(1); _Pragma("unroll") for (int m = 0; m < 4; ++m) _Pragma("unroll") for (int n = 0; n < 2; ++n) _Pragma("unroll") for (int k = 0; k < 2; ++k) \
        acc[ai][bj][m][n] = __builtin_amdgcn_mfma_f32_16x16x32_bf16(Bt[n][k], At[m][k], acc[ai][bj][m][n], 0, 0, 0); __builtin_amdgcn_s_setprio(0); } while (0)
#define PG8_WAIT_V(n) asm volatile("s_waitcnt vmcnt(" #n ")" ::: "memory")
#define PG8_WAIT_L(n) asm volatile("s_waitcnt lgkmcnt(" #n ")" ::: "memory")
#define PG8_BAR __builtin_amdgcn_s_barrier()
#define PG8_SCHED __builtin_amdgcn_sched_barrier(0)
    Unit cur, nxt; int ui = 0;
    if (!S.next(0, cur)) return;
    f32x4 acc[2][2][4][2];
#pragma unroll
    for (int a = 0; a < 2; ++a)
#pragma unroll
        for (int b = 0; b < 2; ++b)
#pragma unroll
            for (int m = 0; m < 4; ++m)
#pragma unroll
                for (int n = 0; n < 2; ++n) acc[a][b][m][n] = (f32x4){0.f, 0.f, 0.f, 0.f};
    bf16x8 At[4][2], B0[2][2], B1[2][2];
    const char* cA = (const char*)g.A + (size_t)cur.pm * tstep; const char* cB = (const char*)g.Bt + (size_t)cur.pn * tstep;
    S.a_ready(cur);
    if constexpr (SP2) {
        PG8_STAGE(PG8_SB(0, 0), cB, voffB); PG8_STAGE(PG8_SB(0, 1), cB + hstep, voffB); PG8_STAGE(PG8_SA(0, 0), cA, voffA); PG8_STAGE(PG8_SA(0, 1), cA + hstep, voffA);
        if (wr == 1) PG8_BAR;
        PG8_WAIT_V(2); PG8_BAR;
        PG8_STAGE(PG8_SB(1, 0), cB + kstep, voffB); PG8_STAGE(PG8_SA(1, 0), cA + kstep, voffA); PG8_STAGE(PG8_SB(1, 1), cB + hstep + kstep, voffB);
        PG8_WAIT_V(6); PG8_BAR;
    } else {
        PG8_STAGE(PG8_SB(0, 0), cB, voffB); PG8_STAGE(PG8_SA(0, 0), cA, voffA); PG8_STAGE(PG8_SB(0, 1), cB + hstep, voffB); PG8_STAGE(PG8_SA(0, 1), cA + hstep, voffA);
        if (wr == 1) PG8_BAR;
        PG8_WAIT_V(4); PG8_BAR;
        PG8_STAGE(PG8_SB(1, 0), cB + kstep, voffB); PG8_STAGE(PG8_SA(1, 0), cA + kstep, voffA); PG8_STAGE(PG8_SB(1, 1), cB + hstep + kstep, voffB);
        PG8_WAIT_V(6); PG8_BAR;
    }
    for (;;) {
        const bool has_next = S.next(ui + 1, nxt);
        const char* nA = has_next ? (const char*)g.A + (size_t)nxt.pm * tstep : cA; const char* nB = has_next ? (const char*)g.Bt + (size_t)nxt.pn * tstep : cB;
        for (int t = 0; t < nt; t += 2) {
            const bool last = (t == nt - 2);
            const char* a1 = cA + (size_t)(t + 1) * kstep;
            const char* a2 = last ? nA : cA + (size_t)(t + 2) * kstep; const char* b2 = last ? nB : cB + (size_t)(t + 2) * kstep;
            const char* a3 = a2 + kstep; const char* b3 = b2 + kstep;
            if (last && has_next) S.a_ready(nxt);
            if constexpr (SP2) {
            PG8_LDB(B0, 0, 0); PG8_LDB(B1, 0, 1); PG8_SCHED; PG8_LDA(At, 0, 0); PG8_STAGE(PG8_SA(1, 1), a1 + hstep, voffA);
            PG8_WAIT_V(8); PG8_WAIT_L(0); PG8_BAR; PG8_MMA(0, 0, At, B0); PG8_MMA(0, 1, At, B1); PG8_BAR; PG8_SCHED;
            PG8_LDA(At, 0, 1); PG8_STAGE(PG8_SB(0, 0), b2, voffB); PG8_STAGE(PG8_SB(0, 1), b2 + hstep, voffB); PG8_STAGE(PG8_SA(0, 0), a2, voffA);
            PG8_WAIT_V(8); PG8_WAIT_L(0); PG8_BAR; PG8_MMA(1, 0, At, B0); PG8_MMA(1, 1, At, B1); PG8_BAR; PG8_SCHED;
            PG8_LDB(B0, 1, 0); PG8_LDB(B1, 1, 1); PG8_SCHED; PG8_LDA(At, 1, 0); PG8_STAGE(PG8_SA(0, 1), a2 + hstep, voffA);
            PG8_WAIT_V(8); PG8_WAIT_L(0); PG8_BAR; PG8_MMA(0, 0, At, B0); PG8_MMA(0, 1, At, B1); PG8_BAR; PG8_SCHED;
            PG8_LDA(At, 1, 1); PG8_STAGE(PG8_SB(1, 0), b3, voffB); PG8_STAGE(PG8_SB(1, 1), b3 + hstep, voffB); PG8_STAGE(PG8_SA(1, 0), a3, voffA);
            PG8_WAIT_V(8); PG8_WAIT_L(0); PG8_BAR; PG8_MMA(1, 0, At, B0); PG8_MMA(1, 1, At, B1); PG8_BAR; PG8_SCHED;
            } else {
            PG8_LDB(B0, 0, 0); PG8_SCHED; PG8_LDA(At, 0, 0); PG8_STAGE(PG8_SA(1, 1), a1 + hstep, voffA);
            PG8_WAIT_L(8); PG8_BAR; PG8_WAIT_L(0); PG8_MMA(0, 0, At, B0); PG8_BAR; PG8_SCHED;
            PG8_LDB(B1, 0, 1); PG8_STAGE(PG8_SB(0, 0), b2, voffB);
            PG8_BAR; PG8_WAIT_L(0); PG8_MMA(0, 1, At, B1); PG8_BAR;
            PG8_LDA(At, 0, 1); PG8_STAGE(PG8_SA(0, 0), a2, voffA);
            PG8_BAR; PG8_WAIT_L(0); PG8_MMA(1, 0, At, B0); PG8_BAR; PG8_SCHED;
            PG8_STAGE(PG8_SB(0, 1), b2 + hstep, voffB);
            PG8_WAIT_V(6); PG8_BAR; PG8_MMA(1, 1, At, B1); PG8_BAR;
            PG8_LDB(B0, 1, 0); PG8_SCHED; PG8_LDA(At, 1, 0); PG8_STAGE(PG8_SA(0, 1), a2 + hstep, voffA);
            PG8_WAIT_L(8); PG8_BAR; PG8_WAIT_L(0); PG8_MMA(0, 0, At, B0); PG8_BAR; PG8_SCHED;
            PG8_LDB(B1, 1, 1); PG8_STAGE(PG8_SB(1, 0), b3, voffB);
            PG8_BAR; PG8_WAIT_L(0); PG8_MMA(0, 1, At, B1); PG8_BAR;
            PG8_LDA(At, 1, 1); PG8_STAGE(PG8_SA(1, 0), a3, voffA);
            PG8_BAR; PG8_WAIT_L(0); PG8_MMA(1, 0, At, B0); PG8_BAR; PG8_SCHED;
            PG8_STAGE(PG8_SB(1, 1), b3 + hstep, voffB);
            PG8_WAIT_V(6); PG8_BAR; PG8_MMA(1, 1, At, B1); PG8_BAR;
            }
        }
        if constexpr (ALIGN_EPI) { if (wr == 0) PG8_BAR; }
        if constexpr (!Epi::AFTER_DRAIN) { E(acc, cur, wr, wc, fr, fq); S.done(cur); }
        if (!has_next) break;
#pragma unroll
        for (int a = 0; a < 2; ++a)
#pragma unroll
            for (int b = 0; b < 2; ++b)
#pragma unroll
                for (int m = 0; m < 4; ++m)
#pragma unroll
                    for (int n = 0; n < 2; ++n) acc[a][b][m][n] = (f32x4){0.f, 0.f, 0.f, 0.f};
        cur = nxt; cA = nA; cB = nB; ++ui;
        if constexpr (ALIGN_EPI) { if (wr == 1) PG8_BAR; }
    }
    PG8_WAIT_V(0);
    if constexpr (!ALIGN_EPI) { if (wr == 0) PG8_BAR; }
    PG8_BAR;
    if constexpr (Epi::AFTER_DRAIN) { E.fused(acc, cur, wr, wc, fr, fq, lds, wid, lane); S.done(cur); }
#undef PG8_SA
#undef PG8_SB
#undef PG8_STAGE
#undef PG8_LDA
#undef PG8_LDB
#undef PG8_MMA
#undef PG8_WAIT_V
#undef PG8_WAIT_L
#undef PG8_BAR
#undef PG8_SCHED
}
}

#define LAS __attribute__((address_space(3)))
typedef unsigned short bf16;
typedef unsigned v4u __attribute__((ext_vector_type(4)));
typedef unsigned v2u __attribute__((ext_vector_type(2)));
typedef float f32x4 __attribute__((ext_vector_type(4)));
typedef float f32x16 __attribute__((ext_vector_type(16)));
typedef short bf16x8 __attribute__((ext_vector_type(8)));
typedef short s16x4 __attribute__((ext_vector_type(4)));
typedef short v4i16_t __attribute__((ext_vector_type(4)));

constexpr int D_MODEL = 2048, BATCH = 4, SEQ = 4096, DEPTH = 4, MTOK = BATCH * SEQ;
constexpr int WIN = 8192, DFF = 5632;
constexpr int C_HQ = 0, C_HF = 1024, C_HB = 2048, C_HI = 3072, C_HG = 4096, C_DQ = 5120, C_DK = 6144, C_DV = 7168;
constexpr float EPS = 1e-6f, LOG2E = 1.4426950408889634f;
constexpr int NTHR = 512, NWAVES = 8;
constexpr int LDS_BYTES = 147456;

constexpr size_t MiB = 1u << 20;
constexpr size_t WS_WIN = 1 * MiB, WS_WOUT = 33 * MiB, WS_WGU = 41 * MiB, WS_WDN = 85 * MiB;
constexpr size_t WS_H = 108 * MiB;
constexpr size_t WS_PROJ = 172 * MiB;
constexpr size_t WS_MIX = 428 * MiB;
constexpr size_t WS_ST = 492 * MiB;
constexpr size_t WS_DEC = 620 * MiB;
constexpr size_t WS_END = 624 * MiB;

struct Params {
    const float* x; const float* norm_mix_w; const float* w_in; const float* lb_logits; const float* onorm_w; const float* qn_w; const float* kn_w;
    const float* da_lambda; const float* subln_w; const float* w_out; const float* norm_ffn_w; const float* w_gate; const float* w_up; const float* w_down;
    float* out; unsigned char* ws;
};

__device__ __forceinline__ unsigned f2bf(float f) { unsigned u = __builtin_bit_cast(unsigned, f); return (u + 0x7fffu + ((u >> 16) & 1u)) >> 16; }
__device__ __forceinline__ unsigned pk2(float lo, float hi) { return f2bf(lo) | (f2bf(hi) << 16); }
__device__ __forceinline__ float bf2f(unsigned short u) { return __uint_as_float(((unsigned)u) << 16); }
__device__ __forceinline__ float bflo(unsigned u) { return __uint_as_float(u << 16); }
__device__ __forceinline__ float bfhi(unsigned u) { return __uint_as_float(u & 0xffff0000u); }
__device__ __forceinline__ float wave_sum(float v) {
#pragma unroll
    for (int o = 1; o < 64; o <<= 1) v += __shfl_xor(v, o);
    return v;
}
__device__ __forceinline__ s16x4 vtr(const LAS unsigned char* p) { return __builtin_bit_cast(s16x4, __builtin_amdgcn_ds_read_tr16_b64_v4i16((LAS v4i16_t*)p)); }
#define MFMA32(a, b, c) __builtin_amdgcn_mfma_f32_32x32x16_bf16((a), (b), (c), 0, 0, 0)
__device__ __forceinline__ bf16x8 pack8(const f32x16& x, int s) {
    v4u p; p.x = pk2(x[8 * s + 0], x[8 * s + 1]); p.y = pk2(x[8 * s + 2], x[8 * s + 3]); p.z = pk2(x[8 * s + 4], x[8 * s + 5]); p.w = pk2(x[8 * s + 6], x[8 * s + 7]);
    return __builtin_bit_cast(bf16x8, p);
}

namespace pg8 {
struct EpiResF32 {
    static constexpr bool PERM = false, AFTER_DRAIN = false;
    const float* base; float* out; int ldc;
    __device__ __forceinline__ void operator()(const f32x4 (&acc)[2][2][4][2], const Unit& u, int wr, int wc, int fr, int fq) const {
        const int row0 = u.pm * BM + wr * 64 + fr, col0 = u.pn * BM + wc * 32 + 4 * fq;
#pragma unroll
        for (int ai = 0; ai < 2; ++ai)
#pragma unroll
            for (int m = 0; m < 4; ++m) { const size_t ro = (size_t)(row0 + ai * HALF + m * 16) * ldc + col0;
#pragma unroll
                for (int bj = 0; bj < 2; ++bj)
#pragma unroll
                    for (int n = 0; n < 2; ++n) { const size_t o = ro + bj * HALF + 16 * n; const f32x4 b = *(const f32x4*)(base + o); *(f32x4*)(out + o) = b + acc[ai][bj][m][n]; } }
    }
};
struct EpiSwiGLU {
    static constexpr bool PERM = true, AFTER_DRAIN = false;
    bf16_t* O; int ldc;
    __device__ __forceinline__ void operator()(const f32x4 (&acc)[2][2][4][2], const Unit& u, int wr, int wc, int fr, int fq) const {
        const int row0 = u.pm * BM + wr * 64 + fr, col0 = u.pn * HALF + wc * 32 + 8 * fq;
#pragma unroll
        for (int ai = 0; ai < 2; ++ai)
#pragma unroll
            for (int m = 0; m < 4; ++m) { bf16_t* rowp = O + (size_t)(row0 + ai * HALF + m * 16) * ldc + col0; float r[8];
#pragma unroll
                for (int n = 0; n < 2; ++n)
#pragma unroll
                    for (int j = 0; j < 4; ++j) { const float g = acc[ai][0][m][n][j], up = acc[ai][1][m][n][j]; r[4 * n + j] = g * __builtin_amdgcn_rcpf(1.f + __expf(-g)) * up; }
                u32x4 w; w.x = cvt_pk_bf16(r[0], r[1]); w.y = cvt_pk_bf16(r[2], r[3]); w.z = cvt_pk_bf16(r[4], r[5]); w.w = cvt_pk_bf16(r[6], r[7]);
                *(u32x4*)rowp = w; }
    }
};
}

__device__ __forceinline__ void transpose_item(const float* W, int K, int N, bf16* WT, int k0, int n0, int drow0, LAS float* scr, int lane) {
#pragma unroll 8
    for (int i = 0; i < 32; ++i) { const int kk = 2 * i + (lane >> 5); scr[kk * 33 + (lane & 31)] = W[(size_t)(k0 + kk) * N + n0 + (lane & 31)]; }
    __builtin_amdgcn_s_waitcnt(0); asm volatile("" ::: "memory");
    const int c = lane & 7;
#pragma unroll
    for (int j = 0; j < 4; ++j) { const int n = (lane >> 3) + 8 * j; const LAS float* s = scr + (8 * c) * 33 + n;
        v4u o; o.x = pk2(s[0 * 33], s[1 * 33]); o.y = pk2(s[2 * 33], s[3 * 33]); o.z = pk2(s[4 * 33], s[5 * 33]); o.w = pk2(s[6 * 33], s[7 * 33]);
        *(v4u*)(WT + (size_t)(drow0 + n) * K + k0 + 8 * c) = o; }
    __builtin_amdgcn_s_waitcnt(0); asm volatile("" ::: "memory");
}
__device__ __forceinline__ void convert_weights(const Params& P, int l, LAS unsigned char* lds, int gw, int ngw, int wave, int lane) {
    LAS float* scr = (LAS float*)(lds + wave * 16384);
    bf16* WTin = (bf16*)(P.ws + WS_WIN); bf16* WTout = (bf16*)(P.ws + WS_WOUT); bf16* WTgu = (bf16*)(P.ws + WS_WGU); bf16* WTdn = (bf16*)(P.ws + WS_WDN);
    const float* w_in = P.w_in + (size_t)l * D_MODEL * WIN; const float* w_out = P.w_out + (size_t)l * D_MODEL * D_MODEL;
    const float* w_gate = P.w_gate + (size_t)l * D_MODEL * DFF; const float* w_up = P.w_up + (size_t)l * D_MODEL * DFF; const float* w_down = P.w_down + (size_t)l * DFF * D_MODEL;
    constexpr int I_IN = (D_MODEL / 64) * (WIN / 32), I_OUT = (D_MODEL / 64) * (D_MODEL / 32), I_G = (D_MODEL / 64) * (DFF / 32), I_DN = (DFF / 64) * (D_MODEL / 32);
    constexpr int NIT = I_IN + I_OUT + 2 * I_G + I_DN;
    for (int it = gw; it < NIT; it += ngw) {
        int r = it;
        if (r < I_IN) { const int nb = WIN / 32, kb = r / nb, n0 = 32 * (r % nb); transpose_item(w_in, D_MODEL, WIN, WTin, 64 * kb, n0, n0, scr, lane); continue; } r -= I_IN;
        if (r < I_OUT) { const int nb = D_MODEL / 32, kb = r / nb, n0 = 32 * (r % nb); transpose_item(w_out, D_MODEL, D_MODEL, WTout, 64 * kb, n0, n0, scr, lane); continue; } r -= I_OUT;
        if (r < I_G) { const int nb = DFF / 32, kb = r / nb, n0 = 32 * (r % nb); transpose_item(w_gate, D_MODEL, DFF, WTgu, 64 * kb, n0, 256 * (n0 >> 7) + (n0 & 127), scr, lane); continue; } r -= I_G;
        if (r < I_G) { const int nb = DFF / 32, kb = r / nb, n0 = 32 * (r % nb); transpose_item(w_up, D_MODEL, DFF, WTgu, 64 * kb, n0, 256 * (n0 >> 7) + 128 + (n0 & 127), scr, lane); continue; } r -= I_G;
        { const int nb = D_MODEL / 32, kb = r / nb, n0 = 32 * (r % nb); transpose_item(w_down, DFF, D_MODEL, WTdn, 64 * kb, n0, n0, scr, lane); }
    }
}
__device__ __forceinline__ void rmsnorm_rows(const float* X, const float* w, bf16* H, int gw, int ngw, int lane) {
    f32x4 wv[8];
#pragma unroll
    for (int j = 0; j < 8; ++j) wv[j] = *(const f32x4*)(w + 4 * lane + 256 * j);
    for (int m = gw; m < MTOK; m += ngw) {
        const f32x4* xr = (const f32x4*)(X + (size_t)m * D_MODEL) + lane;
        f32x4 v[8]; float s = 0.f;
#pragma unroll
        for (int j = 0; j < 8; ++j) { v[j] = xr[64 * j]; s += (v[j].x * v[j].x + v[j].y * v[j].y) + (v[j].z * v[j].z + v[j].w * v[j].w); }
        const float r = rsqrtf(wave_sum(s) * (1.f / D_MODEL) + EPS);
        v2u* o8 = (v2u*)(H + (size_t)m * D_MODEL) + lane;
#pragma unroll
        for (int j = 0; j < 8; ++j) { v2u o; o.x = pk2(v[j].x * r * wv[j].x, v[j].y * r * wv[j].y); o.y = pk2(v[j].z * r * wv[j].z, v[j].w * r * wv[j].w); o8[64 * j] = o; }
    }
}
__device__ __forceinline__ void qknorm_rows(bf16* PROJ, const float* qn_w, const float* kn_w, int gw, int ngw, int lane) {
    const int d0 = 8 * (lane & 7);
    float wq[8], wk[8];
#pragma unroll
    for (int j = 0; j < 8; ++j) { wq[j] = qn_w[d0 + j] * (0.125f * LOG2E); wk[j] = kn_w[d0 + j]; }
    for (int m = gw; m < MTOK; m += ngw) {
#pragma unroll
        for (int it = 0; it < 4; ++it) {
            bf16* p = PROJ + (size_t)m * WIN + C_DQ + it * 512 + 8 * lane;
            const v4u raw = *(const v4u*)p;
            float v[8] = {bflo(raw.x), bfhi(raw.x), bflo(raw.y), bfhi(raw.y), bflo(raw.z), bfhi(raw.z), bflo(raw.w), bfhi(raw.w)};
            float s = 0.f;
#pragma unroll
            for (int j = 0; j < 8; ++j) s += v[j] * v[j];
            s += __shfl_xor(s, 1); s += __shfl_xor(s, 2); s += __shfl_xor(s, 4);
            const float r = rsqrtf(s * (1.f / 64.f) + EPS);
            v4u o;
            if (it < 2) { o.x = pk2(v[0] * r * wq[0], v[1] * r * wq[1]); o.y = pk2(v[2] * r * wq[2], v[3] * r * wq[3]); o.z = pk2(v[4] * r * wq[4], v[5] * r * wq[5]); o.w = pk2(v[6] * r * wq[6], v[7] * r * wq[7]); }
            else        { o.x = pk2(v[0] * r * wk[0], v[1] * r * wk[1]); o.y = pk2(v[2] * r * wk[2], v[3] * r * wk[3]); o.z = pk2(v[4] * r * wk[4], v[5] * r * wk[5]); o.w = pk2(v[6] * r * wk[6], v[7] * r * wk[7]); }
            *(v4u*)p = o;
        }
    }
}

constexpr int KV_PITCH = 272, KV_TILE = 64 * KV_PITCH;
__device__ __forceinline__ void attn_unit(const Params& P, int l, int b, int h, int qb, float lam, float oscale, LAS unsigned char* lds) {
    int tid_o = threadIdx.x; asm volatile("" : "+v"(tid_o));
    const int tid = tid_o, lane = tid & 63, r32 = lane & 31, hh = lane >> 5;
    const int wid = __builtin_amdgcn_readfirstlane(tid >> 6), map = wid >> 2, wq = wid & 3;
    const size_t rowbase = (size_t)b * SEQ;
    const int q0 = qb * 128 + wq * 32;
    const bf16* PROJ = (const bf16*)(P.ws + WS_PROJ);
    bf16x8 qf[4];
    { const bf16* qp = PROJ + (rowbase + q0 + r32) * WIN + C_DQ + h * 128 + map * 64 + hh * 8;
#pragma unroll
      for (int ks = 0; ks < 4; ++ks) qf[ks] = *(const bf16x8*)(qp + 16 * ks); }
    const float cs = exp2f(-(float)(h + 1)) * LOG2E;
    f32x16 o[4];
#pragma unroll
    for (int e = 0; e < 4; ++e)
#pragma unroll
        for (int i = 0; i < 16; ++i) o[e][i] = 0.f;
    float m_run = -1e30f, l_run = 0.f;
    LAS unsigned char* sK = lds; LAS unsigned char* sV = lds + 2 * KV_TILE;
    const int prow = tid >> 4, pc = tid & 15;
    const bf16* kg = PROJ + (rowbase + prow) * WIN + C_DK + h * 128 + pc * 8;
    const bf16* vg = PROJ + (rowbase + prow) * WIN + C_DV + h * 128 + pc * 8;
    const int soff = prow * KV_PITCH + pc * 16;
    v4u kr[2], vr[2];
#pragma unroll
    for (int i = 0; i < 2; ++i) { kr[i] = *(const v4u*)(kg + (size_t)(32 * i) * WIN); vr[i] = *(const v4u*)(vg + (size_t)(32 * i) * WIN); }
#pragma unroll
    for (int i = 0; i < 2; ++i) { *(LAS v4u*)(sK + soff + i * 32 * KV_PITCH) = kr[i]; *(LAS v4u*)(sV + soff + i * 32 * KV_PITCH) = vr[i]; }
    __syncthreads();
    const int qpos = q0 + r32;
    const int vlane = ((lane & 15) >> 2) * KV_PITCH + (16 * ((lane >> 4) & 1) + 4 * (lane & 3)) * 2;
    for (int t = 0; t < SEQ / 64; ++t) {
        const int buf = t & 1;
        if (t + 1 < SEQ / 64) {
#pragma unroll
            for (int i = 0; i < 2; ++i) { kr[i] = *(const v4u*)(kg + (size_t)(64 * (t + 1) + 32 * i) * WIN); vr[i] = *(const v4u*)(vg + (size_t)(64 * (t + 1) + 32 * i) * WIN); }
        }
        const LAS unsigned char* kb = sK + buf * KV_TILE + r32 * KV_PITCH + (map * 64 + hh * 8) * 2;
        f32x16 s0, s1;
#pragma unroll
        for (int i = 0; i < 16; ++i) { s0[i] = 0.f; s1[i] = 0.f; }
#pragma unroll
        for (int ks = 0; ks < 4; ++ks) {
            const bf16x8 a0 = *(const LAS bf16x8*)(kb + ks * 32), a1 = *(const LAS bf16x8*)(kb + 32 * KV_PITCH + ks * 32);
            s0 = MFMA32(a0, qf[ks], s0); s1 = MFMA32(a1, qf[ks], s1);
        }
        const int dbase = qpos - (64 * t + 4 * hh);
        float mx = -1e30f;
#pragma unroll
        for (int i = 0; i < 16; ++i) {
            const float d0 = (float)(dbase - ((i & 3) + 8 * (i >> 2)));
            s0[i] = __builtin_fmaf(-cs, __builtin_fabsf(d0), s0[i]);
            s1[i] = __builtin_fmaf(-cs, __builtin_fabsf(d0 - 32.f), s1[i]);
            mx = __builtin_fmaxf(mx, __builtin_fmaxf(s0[i], s1[i]));
        }
        mx = __builtin_fmaxf(mx, __shfl_xor(mx, 32));
        const float m_new = __builtin_fmaxf(m_run, mx);
        const float alpha = __builtin_amdgcn_exp2f(m_run - m_new);
        m_run = m_new;
        float rs = 0.f;
#pragma unroll
        for (int i = 0; i < 16; ++i) { s0[i] = __builtin_amdgcn_exp2f(s0[i] - m_new); s1[i] = __builtin_amdgcn_exp2f(s1[i] - m_new); rs += s0[i] + s1[i]; }
        l_run = l_run * alpha + rs;
#pragma unroll
        for (int e = 0; e < 4; ++e)
#pragma unroll
            for (int i = 0; i < 16; ++i) o[e][i] *= alpha;
        const LAS unsigned char* vb = sV + buf * KV_TILE + vlane;
#pragma unroll
        for (int ks = 0; ks < 4; ++ks) {
            const bf16x8 pf = (ks < 2) ? pack8(s0, ks & 1) : pack8(s1, ks & 1);
            const int kvA = 32 * (ks >> 1) + 16 * (ks & 1) + 4 * hh;
#pragma unroll
            for (int e = 0; e < 4; ++e) {
                const LAS unsigned char* a = vb + kvA * KV_PITCH + 64 * e;
                const s16x4 lo = vtr(a), hi = vtr(a + 8 * KV_PITCH);
                const bf16x8 vf = __builtin_shufflevector(lo, hi, 0, 1, 2, 3, 4, 5, 6, 7);
                o[e] = MFMA32(vf, pf, o[e]);
            }
        }
        if (t + 1 < SEQ / 64) {
            const int nb = buf ^ 1;
#pragma unroll
            for (int i = 0; i < 2; ++i) { *(LAS v4u*)(sK + nb * KV_TILE + soff + i * 32 * KV_PITCH) = kr[i]; *(LAS v4u*)(sV + nb * KV_TILE + soff + i * 32 * KV_PITCH) = vr[i]; }
        }
        __syncthreads();
    }
    const float l_tot = l_run + __shfl_xor(l_run, 32);
    const float inv = 1.f / l_tot;
    LAS float* X = (LAS float*)lds;
    if (map == 1) {
#pragma unroll
        for (int e = 0; e < 4; ++e)
#pragma unroll
            for (int i = 0; i < 16; ++i) X[(wq * 64 + e * 16 + i) * 64 + lane] = o[e][i] * inv;
    }
    __syncthreads();
    if (map == 0) {
        float ss = 0.f;
#pragma unroll
        for (int e = 0; e < 4; ++e)
#pragma unroll
            for (int i = 0; i < 16; ++i) { const float v = o[e][i] * inv - lam * X[(wq * 64 + e * 16 + i) * 64 + lane]; o[e][i] = v; ss += v * v; }
        ss += __shfl_xor(ss, 32);
        const float r = rsqrtf(ss * (1.f / 128.f) + EPS) * oscale;
        bf16* MIX = (bf16*)(P.ws + WS_MIX) + (rowbase + q0 + r32) * D_MODEL + 1024 + h * 128;
        const float* sw = P.subln_w + l * 128;
#pragma unroll
        for (int e = 0; e < 4; ++e)
#pragma unroll
            for (int g = 0; g < 4; ++g) { const int ec = 32 * e + 8 * g + 4 * hh; const f32x4 w = *(const f32x4*)(sw + ec);
                v2u ov; ov.x = pk2(o[e][4 * g] * r * w.x, o[e][4 * g + 1] * r * w.y); ov.y = pk2(o[e][4 * g + 2] * r * w.z, o[e][4 * g + 3] * r * w.w);
                *(v2u*)(MIX + ec) = ov; }
    }
    __syncthreads();
}

constexpr int HP = 136, HTILE = 64 * HP * 2;
constexpr int KTP = 72;
__device__ __forceinline__ void lower_bound(const Params& P, int l, int dir, int col, float& lbm, float& oml) {
    const float* lg = P.lb_logits + (size_t)dir * DEPTH * 1024 + col;
    const float a0 = lg[0], a1 = lg[1024], a2 = lg[2048], a3 = lg[3072];
    const float mx = fmaxf(fmaxf(a0, a1), fmaxf(a2, a3));
    const float e0 = __expf(a0 - mx), e1 = __expf(a1 - mx), e2 = __expf(a2 - mx), e3 = __expf(a3 - mx);
    const float inv = 1.f / (e0 + e1 + e2 + e3);
    float lb = 0.f;
    if (l >= 1) lb += e1 * inv; if (l >= 2) lb += e2 * inv; if (l >= 3) lb += e3 * inv;
    lb = fminf(fmaxf(lb, 0.f), 1.0f - 1e-6f);
    lbm = fmaxf(lb, 1e-30f); oml = 1.f - lb;
}
__device__ __forceinline__ void hg_local_scan(const bf16* zp, float lbm, float oml, int dir, float (&lf)[32], float (&kk)[32]) {
#pragma unroll
    for (int i = 0; i < 32; ++i) { const float z = bf2f(zp[(size_t)i * WIN]); const float sg = __builtin_amdgcn_rcpf(1.f + __expf(-z)); const float f = lbm + oml * sg; lf[i] = __logf(f); kk[i] = 1.f - f; }
    if (dir == 0) {
#pragma unroll
        for (int i = 1; i < 32; ++i) lf[i] += lf[i - 1];
    } else {
#pragma unroll
        for (int i = 30; i >= 0; --i) lf[i] += lf[i + 1];
    }
}
__device__ __forceinline__ void hg_load_v(const bf16* PROJ, size_t row0, int h, LAS unsigned char* sV, int tid) {
#pragma unroll
    for (int i = 0; i < 2; ++i) { const int p = tid + 512 * i, row = p >> 4, c = p & 15;
        *(LAS v4u*)(sV + row * (HP * 2) + c * 16) = *(const v4u*)(PROJ + (row0 + row) * WIN + C_HI + h * 128 + c * 8); }
}
__device__ __forceinline__ void hg1_unit(const Params& P, int l, int bh, int c, LAS unsigned char* lds) {
    int tid_o = threadIdx.x; asm volatile("" : "+v"(tid_o));
    const int tid = tid_o, lane = tid & 63, r32 = lane & 31, hh = lane >> 5;
    const int wid = __builtin_amdgcn_readfirstlane(tid >> 6);
    const int b = bh >> 3, h = bh & 7;
    const size_t row0 = (size_t)b * SEQ + 64 * c;
    const bf16* PROJ = (const bf16*)(P.ws + WS_PROJ);
    LAS unsigned char* sV = lds; LAS unsigned char* sKT = lds + HTILE;
    hg_load_v(PROJ, row0, h, sV, tid);
    {
        const int dir = tid >> 8, d = (tid >> 1) & 127, half = tid & 1;
        float lbm, oml; lower_bound(P, l, dir, h * 128 + d, lbm, oml);
        float lf[32], kk[32];
        hg_local_scan(PROJ + (row0 + 32 * half) * WIN + (dir ? C_HB : C_HF) + h * 128 + d, lbm, oml, dir, lf, kk);
        const float tot = dir ? lf[0] : lf[31];
        const float other = __shfl_xor(tot, 1);
        const bool far = dir ? (half == 0) : (half == 1);
        const float alast = tot + other, addfull = far ? other : 0.f;
        LAS unsigned char* dst = sKT + ((dir * 128 + d) * KTP + 32 * half) * 2;
#pragma unroll
        for (int g = 0; g < 4; ++g) { float kv[8];
#pragma unroll
            for (int j = 0; j < 8; ++j) kv[j] = kk[8 * g + j] * __expf(alast - (lf[8 * g + j] + addfull));
            v4u o; o.x = pk2(kv[0], kv[1]); o.y = pk2(kv[2], kv[3]); o.z = pk2(kv[4], kv[5]); o.w = pk2(kv[6], kv[7]);
            *(LAS v4u*)(dst + 16 * g) = o; }
        if (half == 0) ((float*)(P.ws + WS_DEC))[((size_t)(dir * 32 + bh) * 64 + c) * 128 + d] = __expf(alast);
    }
    __syncthreads();
    {
        const int dir = wid >> 2, db = wid & 3;
        bf16* ST = (bf16*)(P.ws + WS_ST) + ((size_t)(dir * 32 + bh) * 64 + c) * 16384;
        bf16x8 af[4];
#pragma unroll
        for (int ks = 0; ks < 4; ++ks) af[ks] = *(const LAS bf16x8*)(sKT + ((dir * 128 + 32 * db + r32) * KTP + 16 * ks + 8 * hh) * 2);
        const int vlane = ((lane & 15) >> 2) * (HP * 2) + (16 * ((lane >> 4) & 1) + 4 * (lane & 3)) * 2;
#pragma unroll
        for (int eb = 0; eb < 4; ++eb) {
            f32x16 acc;
#pragma unroll
            for (int i = 0; i < 16; ++i) acc[i] = 0.f;
#pragma unroll
            for (int ks = 0; ks < 4; ++ks) {
                const LAS unsigned char* a = sV + (16 * ks + 8 * hh) * (HP * 2) + 64 * eb + vlane;
                const s16x4 lo = vtr(a), hi = vtr(a + 4 * (HP * 2));
                const bf16x8 vf = __builtin_shufflevector(lo, hi, 0, 1, 2, 3, 4, 5, 6, 7);
                acc = MFMA32(af[ks], vf, acc);
            }
            bf16* dst = ST + (size_t)(32 * eb + r32) * 128 + 32 * db + 4 * hh;
#pragma unroll
            for (int g = 0; g < 4; ++g) { v2u ov; ov.x = pk2(acc[4 * g], acc[4 * g + 1]); ov.y = pk2(acc[4 * g + 2], acc[4 * g + 3]); *(v2u*)(dst + 8 * g) = ov; }
        }
    }
    __syncthreads();
}
__device__ __forceinline__ void hg2_scan(const Params& P, int gtid, int ngt) {
    for (int idx = gtid; idx < 64 * 2048; idx += ngt) {
        const int stream = idx >> 11, v16 = idx & 2047, dir = stream >> 5;
        bf16* base = (bf16*)(P.ws + WS_ST) + (size_t)stream * 64 * 16384 + v16 * 8;
        const float* dec = (const float*)(P.ws + WS_DEC) + (size_t)stream * 64 * 128 + (v16 & 15) * 8;
        float S[8];
#pragma unroll
        for (int j = 0; j < 8; ++j) S[j] = 0.f;
#pragma unroll 4
        for (int k = 0; k < 64; ++k) {
            const int c = dir ? 63 - k : k;
            v4u* p = (v4u*)(base + (size_t)c * 16384);
            const v4u u = *p;
            const f32x4 d0 = *(const f32x4*)(dec + c * 128), d1 = *(const f32x4*)(dec + c * 128 + 4);
            v4u o; o.x = pk2(S[0], S[1]); o.y = pk2(S[2], S[3]); o.z = pk2(S[4], S[5]); o.w = pk2(S[6], S[7]);
            *p = o;
            S[0] = d0.x * S[0] + bflo(u.x); S[1] = d0.y * S[1] + bfhi(u.x); S[2] = d0.z * S[2] + bflo(u.y); S[3] = d0.w * S[3] + bfhi(u.y);
            S[4] = d1.x * S[4] + bflo(u.z); S[5] = d1.y * S[5] + bfhi(u.z); S[6] = d1.z * S[6] + bflo(u.w); S[7] = d1.w * S[7] + bfhi(u.w);
        }
    }
}
__device__ __forceinline__ void hg3_unit(const Params& P, int l, int bh, int c, LAS unsigned char* lds) {
    int tid_o = threadIdx.x; asm volatile("" : "+v"(tid_o));
    const int tid = tid_o, lane = tid & 63, r32 = lane & 31, hh = lane >> 5;
    const int wid = __builtin_amdgcn_readfirstlane(tid >> 6);
    const int b = bh >> 3, h = bh & 7;
    const size_t row0 = (size_t)b * SEQ + 64 * c;
    const bf16* PROJ = (const bf16*)(P.ws + WS_PROJ);
    LAS unsigned char* sV = lds;
    LAS unsigned char* sQi = lds + HTILE;
    LAS unsigned char* sKm = lds + 3 * HTILE;
    LAS unsigned char* sQm = lds + 5 * HTILE;
    LAS unsigned char* sSc = lds + 7 * HTILE;
    hg_load_v(PROJ, row0, h, sV, tid);
    {
        const int dir = tid >> 8, d = (tid >> 1) & 127, half = tid & 1;
        float lbm, oml; lower_bound(P, l, dir, h * 128 + d, lbm, oml);
        float lf[32], kk[32];
        hg_local_scan(PROJ + (row0 + 32 * half) * WIN + (dir ? C_HB : C_HF) + h * 128 + d, lbm, oml, dir, lf, kk);
        const float tot = dir ? lf[0] : lf[31];
        const float other = __shfl_xor(tot, 1);
        const bool far = dir ? (half == 0) : (half == 1);
        const float addfull = far ? other : 0.f, subrel = far ? 0.f : tot;
        const bf16* qp = PROJ + (row0 + 32 * half) * WIN + C_HQ + h * 128 + d;
        const int o0 = dir * HTILE + ((32 * half) * HP + d) * 2;
#pragma unroll
        for (int i = 0; i < 32; ++i) {
            const float qv = bf2f(qp[(size_t)i * WIN]);
            const float arel = lf[i] - subrel;
            const float em = __expf(arel);
            *(LAS unsigned short*)(sQi + o0 + i * HP * 2) = (unsigned short)f2bf(qv * __expf(lf[i] + addfull));
            *(LAS unsigned short*)(sQm + o0 + i * HP * 2) = (unsigned short)f2bf(qv * em);
            *(LAS unsigned short*)(sKm + o0 + i * HP * 2) = (unsigned short)f2bf(kk[i] * __expf(-arel));
        }
    }
    __syncthreads();
    {
        const int dir = wid >> 2, I = (wid >> 1) & 1, J = wid & 1;
        const bool dead = dir ? (I == 1 && J == 0) : (I == 0 && J == 1);
        f32x16 acc;
#pragma unroll
        for (int i = 0; i < 16; ++i) acc[i] = 0.f;
        if (!dead) {
            const LAS unsigned char* ka = sKm + dir * HTILE + ((32 * J + r32) * HP + 8 * hh) * 2;
            const LAS unsigned char* qa = sQm + dir * HTILE + ((32 * I + r32) * HP + 8 * hh) * 2;
#pragma unroll
            for (int ks = 0; ks < 8; ++ks) acc = MFMA32(*(const LAS bf16x8*)(ka + 32 * ks), *(const LAS bf16x8*)(qa + 32 * ks), acc);
        }
        const int tt = 32 * I + r32;
        LAS unsigned char* dst = sSc + ((dir * 64 + tt) * KTP + 32 * J + 4 * hh) * 2;
#pragma unroll
        for (int g = 0; g < 4; ++g) { float v[4];
#pragma unroll
            for (int j = 0; j < 4; ++j) { const int s = 32 * J + 8 * g + 4 * hh + j; const bool keep = dir ? (s >= tt) : (s <= tt); v[j] = keep ? acc[4 * g + j] : 0.f; }
            v2u ov; ov.x = pk2(v[0], v[1]); ov.y = pk2(v[2], v[3]); *(LAS v2u*)(dst + 16 * g) = ov; }
    }
    __syncthreads();
    {
        const int tb = wid >> 2, eb = wid & 3;
        f32x16 acc;
#pragma unroll
        for (int i = 0; i < 16; ++i) acc[i] = 0.f;
        const int vlane = ((lane & 15) >> 2) * (HP * 2) + (16 * ((lane >> 4) & 1) + 4 * (lane & 3)) * 2;
#pragma unroll
        for (int dir = 0; dir < 2; ++dir) {
            const bf16* Sp = (const bf16*)(P.ws + WS_ST) + ((size_t)(dir * 32 + bh) * 64 + c) * 16384 + (size_t)(32 * eb + r32) * 128 + 8 * hh;
            const LAS unsigned char* qa = sQi + dir * HTILE + ((32 * tb + r32) * HP + 8 * hh) * 2;
#pragma unroll
            for (int ks = 0; ks < 8; ++ks) acc = MFMA32(*(const LAS bf16x8*)(qa + 32 * ks), *(const bf16x8*)(Sp + 16 * ks), acc);
            const LAS unsigned char* sa = sSc + ((dir * 64 + 32 * tb + r32) * KTP + 8 * hh) * 2;
#pragma unroll
            for (int ks = 0; ks < 4; ++ks) {
                const LAS unsigned char* a = sV + (16 * ks + 8 * hh) * (HP * 2) + 64 * eb + vlane;
                const s16x4 lo = vtr(a), hi = vtr(a + 4 * (HP * 2));
                const bf16x8 vf = __builtin_shufflevector(lo, hi, 0, 1, 2, 3, 4, 5, 6, 7);
                acc = MFMA32(*(const LAS bf16x8*)(sa + 32 * ks), vf, acc);
            }
        }
        LAS float* sO = (LAS float*)sQm;
#pragma unroll
        for (int i = 0; i < 16; ++i) sO[(32 * tb + (i & 3) + 8 * (i >> 2) + 4 * hh) * 132 + 32 * eb + r32] = acc[i];
    }
    __syncthreads();
    {
        const int t = tid >> 3, e0 = (tid & 7) * 16;
        const LAS float* so = (const LAS float*)sQm + t * 132 + e0;
        float v[16]; float ss = 0.f;
#pragma unroll
        for (int j = 0; j < 16; ++j) { v[j] = so[j]; ss += v[j] * v[j]; }
        ss += __shfl_xor(ss, 1); ss += __shfl_xor(ss, 2); ss += __shfl_xor(ss, 4);
        const float r = rsqrtf(ss * (1.f / 128.f) + EPS);
        const bf16* gp = PROJ + (row0 + t) * WIN + C_HG + h * 128 + e0;
        const v4u g0 = *(const v4u*)gp, g1 = *(const v4u*)(gp + 8);
        const float gv[16] = {bflo(g0.x), bfhi(g0.x), bflo(g0.y), bfhi(g0.y), bflo(g0.z), bfhi(g0.z), bflo(g0.w), bfhi(g0.w),
                              bflo(g1.x), bfhi(g1.x), bflo(g1.y), bfhi(g1.y), bflo(g1.z), bfhi(g1.z), bflo(g1.w), bfhi(g1.w)};
        const float* ow = P.onorm_w + l * 128 + e0;
        float y[16];
#pragma unroll
        for (int j = 0; j < 16; ++j) { const float g = gv[j]; y[j] = v[j] * r * ow[j] * (g * __builtin_amdgcn_rcpf(1.f + __expf(-g))); }
        bf16* mp = (bf16*)(P.ws + WS_MIX) + (row0 + t) * D_MODEL + h * 128 + e0;
        v4u o0, o1;
        o0.x = pk2(y[0], y[1]); o0.y = pk2(y[2], y[3]); o0.z = pk2(y[4], y[5]); o0.w = pk2(y[6], y[7]);
        o1.x = pk2(y[8], y[9]); o1.y = pk2(y[10], y[11]); o1.z = pk2(y[12], y[13]); o1.w = pk2(y[14], y[15]);
        *(v4u*)mp = o0; *(v4u*)(mp + 8) = o1;
    }
    __syncthreads();
}

__global__ void __launch_bounds__(NTHR, 2) hybrid_fwd(Params P) {
    extern __shared__ __attribute__((aligned(16))) unsigned char lds_raw[];
    cg::grid_group grid = cg::this_grid();
    LAS unsigned char* lds = (LAS unsigned char*)lds_raw;
    const int G = gridDim.x, bx = blockIdx.x, ngw = G * NWAVES;
#define TIDS() int tid = threadIdx.x; asm volatile("" : "+v"(tid)); const int lane = tid & 63, wave = __builtin_amdgcn_readfirstlane(tid >> 6), gw = bx * NWAVES + wave; (void)lane; (void)gw
    bf16* H = (bf16*)(P.ws + WS_H); bf16* PROJ = (bf16*)(P.ws + WS_PROJ); bf16* MIX = (bf16*)(P.ws + WS_MIX); bf16* U = (bf16*)(P.ws + WS_PROJ);
    const bf16* WTin = (const bf16*)(P.ws + WS_WIN); const bf16* WTout = (const bf16*)(P.ws + WS_WOUT); const bf16* WTgu = (const bf16*)(P.ws + WS_WGU); const bf16* WTdn = (const bf16*)(P.ws + WS_WDN);

    for (int l = 0; l < DEPTH; ++l) {
        const float* xin = (l == 0) ? P.x : P.out;
#ifndef SKIP_P0
        { TIDS(); convert_weights(P, l, lds, gw, ngw, wave, lane);
        rmsnorm_rows(xin, P.norm_mix_w + l * D_MODEL, H, gw, ngw, lane); }
#endif

        grid.sync();
#ifndef SKIP_P1
        { pg8::Gemm g{H, WTin, MTOK, WIN, D_MODEL}; pg8::StaticOrder S; S.init(MTOK, WIN, G, bx);
          pg8::EpiBf16<0> E{PROJ, WIN, nullptr, 0, 0, 1.f};
          pg8::gemm_phase<pg8::EpiBf16<0>, pg8::StaticOrder, true, true>(lds, g, S, E); }
#endif

        grid.sync();
#ifndef SKIP_P1B
        { TIDS(); qknorm_rows(PROJ, P.qn_w + l * 64, P.kn_w + l * 64, gw, ngw, lane); }
#endif

        grid.sync();
        {
            TIDS();
            const float* lp = P.da_lambda + l * 256;
            const float sa = wave_sum(lp[lane] * lp[64 + lane]), sb = wave_sum(lp[128 + lane] * lp[192 + lane]);
            const float lam_init = 0.8f - 0.6f * expf(-0.3f * (float)l);
            const float lam = expf(sa) - expf(sb) + lam_init;
#ifndef SKIP_H1
            for (int u = bx; u < 2048; u += G) hg1_unit(P, l, u >> 6, u & 63, lds);
#endif
#ifndef SKIP_ATT
            for (int u = bx; u < 1024; u += G) { const int bh = u >> 5, qb = u & 31; attn_unit(P, l, bh >> 3, bh & 7, qb, lam, 1.f - lam_init, lds); }
#endif
        }
        grid.sync();
#ifndef SKIP_H2
        { TIDS(); hg2_scan(P, bx * NTHR + tid, G * NTHR); }
#endif
        grid.sync();
#ifndef SKIP_H3
        for (int u = bx; u < 2048; u += G) hg3_unit(P, l, u >> 6, u & 63, lds);
#endif
        grid.sync();
#ifndef SKIP_P5
        { pg8::Gemm g{MIX, WTout, MTOK, D_MODEL, D_MODEL}; pg8::StaticOrder S; S.init(MTOK, D_MODEL, G, bx);
          pg8::EpiResF32 E{xin, P.out, D_MODEL};
          pg8::gemm_phase<pg8::EpiResF32, pg8::StaticOrder, true, true>(lds, g, S, E); }
#endif

        grid.sync();
#ifndef SKIP_P6
        { TIDS(); rmsnorm_rows(P.out, P.norm_ffn_w + l * D_MODEL, H, gw, ngw, lane); }
#endif

        grid.sync();
#ifndef SKIP_P7
        { pg8::Gemm g{H, WTgu, MTOK, 2 * DFF, D_MODEL}; pg8::StaticOrder S; S.init(MTOK, 2 * DFF, G, bx);
          pg8::EpiSwiGLU E{U, DFF};
          pg8::gemm_phase<pg8::EpiSwiGLU, pg8::StaticOrder, true, true>(lds, g, S, E); }
#endif

        grid.sync();
#ifndef SKIP_P8
        { pg8::Gemm g{U, WTdn, MTOK, D_MODEL, DFF}; pg8::StaticOrder S; S.init(MTOK, D_MODEL, G, bx);
          pg8::EpiResF32 E{P.out, P.out, D_MODEL};
          pg8::gemm_phase<pg8::EpiResF32, pg8::StaticOrder, true, true>(lds, g, S, E); }
#endif

        grid.sync();
    }
}

extern "C" void kernel_launch(void* const* d_in, const int* in_sizes, int n_in, void* d_out, int out_size, void* d_ws, size_t ws_size, hipStream_t stream) {
    static int grid_blocks = 0;
    if (grid_blocks == 0) {
        if (n_in != 14 || ws_size < WS_END) { fprintf(stderr, "kernel_launch: unexpected n_in %d or ws_size %zu (need %zu)\n", n_in, ws_size, (size_t)WS_END); grid_blocks = -1; return; }
        int dev = 0, cus = 0, per_cu = 0;
        hipGetDevice(&dev);
        hipDeviceGetAttribute(&cus, hipDeviceAttributeMultiprocessorCount, dev);
        if (hipFuncSetAttribute((const void*)hybrid_fwd, hipFuncAttributeMaxDynamicSharedMemorySize, LDS_BYTES) != hipSuccess) fprintf(stderr, "kernel_launch: hipFuncSetAttribute failed\n");
        if (hipOccupancyMaxActiveBlocksPerMultiprocessor(&per_cu, (const void*)hybrid_fwd, NTHR, LDS_BYTES) != hipSuccess || per_cu < 1) { fprintf(stderr, "kernel_launch: occupancy query gave %d\n", per_cu); per_cu = 1; }
        (void)hipGetLastError();
        grid_blocks = cus * per_cu;
    }
    if (grid_blocks < 0) return;
    Params p{};
    p.x = (const float*)d_in[0]; p.norm_mix_w = (const float*)d_in[1]; p.w_in = (const float*)d_in[2]; p.lb_logits = (const float*)d_in[3]; p.onorm_w = (const float*)d_in[4];
    p.qn_w = (const float*)d_in[5]; p.kn_w = (const float*)d_in[6]; p.da_lambda = (const float*)d_in[7]; p.subln_w = (const float*)d_in[8]; p.w_out = (const float*)d_in[9];
    p.norm_ffn_w = (const float*)d_in[10]; p.w_gate = (const float*)d_in[11]; p.w_up = (const float*)d_in[12]; p.w_down = (const float*)d_in[13];
    p.out = (float*)d_out; p.ws = (unsigned char*)d_ws;
    void* args[] = {&p};
    hipError_t e = hipLaunchCooperativeKernel((const void*)hybrid_fwd, dim3(grid_blocks), dim3(NTHR), args, LDS_BYTES, stream);
    if (e != hipSuccess) fprintf(stderr, "kernel_launch: cooperative launch failed: %s (grid %d)\n", hipGetErrorString(e), grid_blocks);
}
```

```cpp
#include <hip/hip_runtime.h>
#include <hip/hip_cooperative_groups.h>
#include <cstdio>
#include <cstdint>
namespace cg = cooperative_groups;
namespace pg8 {
#define PG8_LAS __attribute__((address_space(3)))
typedef unsigned short bf16_t;
typedef short bf16x8 __attribute__((ext_vector_type(8)));
typedef float f32x4 __attribute__((ext_vector_type(4)));
typedef unsigned u32x4 __attribute__((ext_vector_type(4)));
constexpr int BM = 256, BK = 64, HALF = 128, HTB = HALF * BK * 2  , STAGE_BYTES = 8 * HTB, NXCD = 8, WGM = 8;

__host__ __device__ __forceinline__ int lds_byte(int r, int c) { const int st = (r >> 4) * 2 + (c >> 5), rr = r & 15, cc = c & 31, ob = rr * 64 + cc * 2; return st * 1024 + (ob ^ (((ob >> 9) & 1) << 5)); }
__host__ __device__ __forceinline__ void stage_rc(int b, int& R, int& C) { const int st = b / 1024, sb = b % 1024, swz = sb ^ (((sb >> 9) & 1) << 5); R = (st >> 1) * 16 + swz / 64; C = (st & 1) * 32 + (swz % 64) / 2; }
__host__ __device__ __forceinline__ int perm32(int rho) { const int n = rho >> 4, i = rho & 15; return 8 * (i >> 2) + 4 * n + (i & 3); }

struct Unit { int pm, pn; };
struct Gemm { const bf16_t* A; const bf16_t* Bt; int M, N, K; };

struct StaticOrder {
    int nM, nN, nwg, G, c;
    __host__ __device__ void init(int M, int N, int G_, int c_) { nM = M / BM; nN = N / BM; nwg = nM * nN; G = G_; c = c_; }
    __host__ __device__ bool next(int i, Unit& u) const {
        const long L = (long)i * G + c; if (L >= nwg) return false;
        int wgid = (int)L; { const int q = nwg / NXCD, r = nwg % NXCD, xcd = wgid % NXCD, off = wgid / NXCD; wgid = (xcd < r ? xcd * (q + 1) : r * (q + 1) + (xcd - r) * q) + off; }
        const int nig = WGM * nN, gid = wgid / nig, fm = gid * WGM, gsz = (nM - fm) < WGM ? (nM - fm) : WGM;
        u.pm = fm + ((wgid % nig) % gsz); u.pn = (wgid % nig) / gsz; return true;
    }
    __device__ __forceinline__ void a_ready(const Unit&) const {}
    __device__ __forceinline__ void done(const Unit&) const {}
};

__device__ __forceinline__ unsigned cvt_pk_bf16(float lo, float hi) { unsigned r; asm volatile("v_cvt_pk_bf16_f32 %0, %1, %2" : "=v"(r) : "v"(lo), "v"(hi)); return r; }
typedef float f32x2 __attribute__((ext_vector_type(2)));
__device__ __forceinline__ f32x2 gelu_pk(f32x2 v) {
    const f32x2 av = __builtin_elementwise_abs(v), d = av * 0.2316418882f + 1.0f;
    f32x2 t; t.x = __builtin_amdgcn_rcpf(d.x); t.y = __builtin_amdgcn_rcpf(d.y);
    f32x2 q = t * 0.5307027145f + (-0.7265760135f); q = q * t + 0.7107068705f; q = q * t + (-0.142248368f); q = q * t + 0.127414796f; q = q * t;
    const f32x2 s = (v * v) * (-0.72134752044f);
    f32x2 e; e.x = __builtin_amdgcn_exp2f(s.x); e.y = __builtin_amdgcn_exp2f(s.y);
    const f32x2 m = v * (q * e), r = v - m;
    f32x2 o; o.x = v.x < 0.f ? m.x : r.x; o.y = v.y < 0.f ? m.y : r.y; return o;
}

template <int ACT  > struct EpiBf16 {
    static constexpr bool PERM = true, AFTER_DRAIN = false; static_assert(ACT == 0 || ACT == 1, "EpiBf16: ACT is 0 (none) or 1 (gelu_pk)");
    bf16_t* O; int ldc; const float* bias; int split_cols; size_t split_stride; float scale0;
    __device__ __forceinline__ void operator()(const f32x4 (&acc)[2][2][4][2], const Unit& u, int wr, int wc, int fr, int fq) const {
        const int row0 = u.pm * BM + wr * 64 + fr; int colt = u.pn * BM; bf16_t* base = O;
        float sc = 1.f; if (split_cols) { const int t = colt / split_cols; base += (size_t)t * split_stride; colt -= t * split_cols; if (t == 0) sc = scale0; }
        const int col0 = colt + wc * 32 + 8 * fq, bcol0 = u.pn * BM + wc * 32 + 8 * fq;
        f32x4 bv[2][2];
#pragma unroll
        for (int bj = 0; bj < 2; ++bj)
#pragma unroll
            for (int n = 0; n < 2; ++n) bv[bj][n] = bias ? *(const f32x4*)(bias + bcol0 + bj * HALF + 4 * n) : (f32x4){0.f, 0.f, 0.f, 0.f};
#pragma unroll
        for (int ai = 0; ai < 2; ++ai)
#pragma unroll
            for (int m = 0; m < 4; ++m) { bf16_t* rowp = base + (size_t)(row0 + ai * HALF + m * 16) * ldc + col0;
#pragma unroll
                for (int bj = 0; bj < 2; ++bj) { f32x4 v0 = acc[ai][bj][m][0] + bv[bj][0], v1 = acc[ai][bj][m][1] + bv[bj][1];
                    if (ACT == 1) { f32x2 a = gelu_pk((f32x2){v0[0], v0[1]}), b = gelu_pk((f32x2){v0[2], v0[3]}), c = gelu_pk((f32x2){v1[0], v1[1]}), d = gelu_pk((f32x2){v1[2], v1[3]});
                        v0 = (f32x4){a.x, a.y, b.x, b.y}; v1 = (f32x4){c.x, c.y, d.x, d.y}; }
                    v0 = v0 * sc; v1 = v1 * sc; u32x4 w; w.x = cvt_pk_bf16(v0[0], v0[1]); w.y = cvt_pk_bf16(v0[2], v0[3]); w.z = cvt_pk_bf16(v1[0], v1[1]); w.w = cvt_pk_bf16(v1[2], v1[3]);
                    *(u32x4*)(rowp + bj * HALF) = w; } }
    }
};

struct PanelStats {
    unsigned* xbuf;
    unsigned* cnt;
    unsigned* tmo;
    int ntn; float eps;
    unsigned code;
    __device__ __forceinline__ bool run(const f32x4 (&v)[2][2][4][2], const Unit& u, int wr, int wc, int fr, int fq, PG8_LAS unsigned char* lds, int wid, int lane) const {
        typedef float f32x2v __attribute__((ext_vector_type(2)));
        PG8_LAS f32x2v* P = (PG8_LAS f32x2v*)lds;
        PG8_LAS f32x2v* S = (PG8_LAS f32x2v*)(lds + 8192);
        PG8_LAS unsigned* flag = (PG8_LAS unsigned*)(lds + 8192 + 2048);
#pragma unroll
        for (int ai = 0; ai < 2; ++ai)
#pragma unroll
            for (int m = 0; m < 4; ++m) {
                float s = 0.f;
#pragma unroll
                for (int bj = 0; bj < 2; ++bj)
#pragma unroll
                    for (int n = 0; n < 2; ++n) { const f32x4 x = v[ai][bj][m][n]; s += (x[0] + x[1]) + (x[2] + x[3]); }
                s += __shfl_xor(s, 16); s += __shfl_xor(s, 32);
                const float mw = s * (1.0f / 64.0f); float q = 0.f;
#pragma unroll
                for (int bj = 0; bj < 2; ++bj)
#pragma unroll
                    for (int n = 0; n < 2; ++n) { const f32x4 d = v[ai][bj][m][n] - mw; q += (d[0] * d[0] + d[1] * d[1]) + (d[2] * d[2] + d[3] * d[3]); }
                q += __shfl_xor(q, 16); q += __shfl_xor(q, 32);
                if (fq == 0) P[(ai * HALF + wr * 64 + m * 16 + fr) * 4 + wc] = (f32x2v){mw, q};
            }
        asm volatile("s_waitcnt lgkmcnt(0)" ::: "memory"); __builtin_amdgcn_s_barrier(); asm volatile("" ::: "memory");
#if defined(BROKEN_EXCHANGE_NO_WAIT)
#warning BROKEN CONTROL BUILD: the row-statistics exchange does not wait; results are wrong by design
        if (blockIdx.x >= 64) { const long long t0_ = clock64(); while (clock64() - t0_ < 60000) __builtin_amdgcn_s_sleep(8); }
#endif
        const int row = wid * 32 + (lane & 31);
        if (lane < 32) {
            const f32x2v a = P[row * 4 + 0], b = P[row * 4 + 1], c = P[row * 4 + 2], d = P[row * 4 + 3];
            const float mt = (a.x + b.x + c.x + d.x) * 0.25f;
            const float da = a.x - mt, db = b.x - mt, dc = c.x - mt, dd = d.x - mt;
            const float m2 = (a.y + b.y) + (c.y + d.y) + 64.0f * ((da * da + db * db) + (dc * dc + dd * dd));
            unsigned long long* slot = (unsigned long long*)xbuf + ((size_t)(u.pm * BM + row) * 4 + u.pn);
            __hip_atomic_store(slot, ((unsigned long long)__float_as_uint(m2) << 32) | __float_as_uint(mt), __ATOMIC_RELAXED, __HIP_MEMORY_SCOPE_AGENT);
        }
        asm volatile("s_waitcnt vmcnt(0)" ::: "memory");
        if (lane == 0) __hip_atomic_fetch_add(cnt + 64 * u.pm, 1u, __ATOMIC_RELAXED, __HIP_MEMORY_SCOPE_AGENT);
        if (wid == 0) {
            bool dead = false; const unsigned long long t0 = __builtin_amdgcn_s_memrealtime(); const unsigned want = 8u * (unsigned)ntn;
            for (;;) {
#if defined(BROKEN_EXCHANGE_NO_WAIT)
                break;
#endif
                if ((unsigned)__builtin_amdgcn_readfirstlane(__hip_atomic_load(cnt + 64 * u.pm, __ATOMIC_RELAXED, __HIP_MEMORY_SCOPE_AGENT)) >= want) break;
                if (__builtin_amdgcn_s_memrealtime() - t0 > 2000000ull) {
                    if (lane == 0) { unsigned expect = 0u; __hip_atomic_compare_exchange_strong(tmo + 1, &expect, code | (unsigned)(u.pm & 0xff), __ATOMIC_RELAXED, __ATOMIC_RELAXED, __HIP_MEMORY_SCOPE_AGENT);
                                     __hip_atomic_store(tmo, 1u, __ATOMIC_RELAXED, __HIP_MEMORY_SCOPE_AGENT); }
                    dead = true; break; }
                __builtin_amdgcn_s_sleep(2);
            }
            __builtin_amdgcn_fence(__ATOMIC_ACQUIRE, "agent");
            if (lane == 0) flag[0] = dead ? 1u : 0u;
        }
        asm volatile("s_waitcnt vmcnt(0) lgkmcnt(0)" ::: "memory"); __builtin_amdgcn_s_barrier(); asm volatile("" ::: "memory");
        const bool bad = flag[0] != 0u;
        if (lane < 32) {
            const unsigned long long* slot = (const unsigned long long*)xbuf + (size_t)(u.pm * BM + row) * 4; float mt[4], m2[4]; float ms = 0.f;
#pragma unroll
            for (int t = 0; t < 4; ++t) { if (t < ntn) { const unsigned long long w = __hip_atomic_load(slot + t, __ATOMIC_RELAXED, __HIP_MEMORY_SCOPE_AGENT); mt[t] = __uint_as_float((unsigned)w); m2[t] = __uint_as_float((unsigned)(w >> 32)); } else { mt[t] = 0.f; m2[t] = 0.f; } ms += mt[t]; }
            const float mean = ms / (float)ntn; float q = 0.f;
#pragma unroll
            for (int t = 0; t < 4; ++t) if (t < ntn) { const float dm = mt[t] - mean; q += m2[t] + 256.0f * dm * dm; }
            S[row] = (f32x2v){mean, 1.0f / sqrtf(q / (256.0f * (float)ntn) + eps)};
        }
        asm volatile("s_waitcnt lgkmcnt(0)" ::: "memory"); __builtin_amdgcn_s_barrier(); asm volatile("" ::: "memory");
        return bad;
    }
};
struct EpiLnRes {
    static constexpr bool PERM = false, AFTER_DRAIN = true;
    const float* base; float* out; int ldc; const float* bias; PanelStats st; unsigned poison;
    __device__ __forceinline__ void fused(f32x4 (&acc)[2][2][4][2], const Unit& u, int wr, int wc, int fr, int fq, PG8_LAS unsigned char* lds, int wid, int lane) const {
        typedef float f32x2v __attribute__((ext_vector_type(2)));
        const PG8_LAS f32x2v* S = (const PG8_LAS f32x2v*)(lds + 8192);
        const int col0 = u.pn * BM + wc * 32 + 4 * fq;
#pragma unroll
        for (int bj = 0; bj < 2; ++bj)
#pragma unroll
            for (int n = 0; n < 2; ++n) { const f32x4 bv = bias ? *(const f32x4*)(bias + col0 + bj * HALF + n * 16) : (f32x4){0.f, 0.f, 0.f, 0.f};
#pragma unroll
                for (int ai = 0; ai < 2; ++ai)
#pragma unroll
                    for (int m = 0; m < 4; ++m) acc[ai][bj][m][n] += bv; }
        f32x4 pre[4][2][2];
#pragma unroll
        for (int m = 0; m < 4; ++m) { const size_t off = (size_t)(u.pm * BM + wr * 64 + m * 16 + fr) * ldc + col0;
#pragma unroll
            for (int bj = 0; bj < 2; ++bj)
#pragma unroll
                for (int n = 0; n < 2; ++n) pre[m][bj][n] = *(const f32x4*)(base + off + bj * HALF + n * 16); }
        const bool bad = st.run(acc, u, wr, wc, fr, fq, lds, wid, lane) || poison != 0u;
        const float qnan = __builtin_nanf("");
#pragma unroll
        for (int ai = 0; ai < 2; ++ai)
#pragma unroll
            for (int m = 0; m < 4; ++m) { const int r = ai * HALF + wr * 64 + m * 16 + fr; const f32x2v sr = S[r]; const size_t off = (size_t)(u.pm * BM + r) * ldc + col0;
#pragma unroll
                for (int bj = 0; bj < 2; ++bj)
#pragma unroll
                    for (int n = 0; n < 2; ++n) { const f32x4 bs = ai == 0 ? pre[m][bj][n] : *(const f32x4*)(base + off + bj * HALF + n * 16); f32x4 o = bs + (acc[ai][bj][m][n] - sr.x) * sr.y;
                        if (bad) o = (f32x4){qnan, qnan, qnan, qnan}; *(f32x4*)(out + off + bj * HALF + n * 16) = o; }
                if (m & 1) asm volatile("" ::: "memory"); }
    }
};
struct EpiLnResLn {
    static constexpr bool PERM = false, AFTER_DRAIN = true;
    const float* base; float* out; bf16_t* xn; int ldc; const float* bias; PanelStats st1, st2; unsigned poison;
    __device__ __forceinline__ void fused(f32x4 (&acc)[2][2][4][2], const Unit& u, int wr, int wc, int fr, int fq, PG8_LAS unsigned char* lds, int wid, int lane) const {
        typedef float f32x2v __attribute__((ext_vector_type(2))); typedef unsigned u32x2v __attribute__((ext_vector_type(2)));
        const PG8_LAS f32x2v* S = (const PG8_LAS f32x2v*)(lds + 8192);
        const int col0 = u.pn * BM + wc * 32 + 4 * fq;
#pragma unroll
        for (int bj = 0; bj < 2; ++bj)
#pragma unroll
            for (int n = 0; n < 2; ++n) { const f32x4 bv = bias ? *(const f32x4*)(bias + col0 + bj * HALF + n * 16) : (f32x4){0.f, 0.f, 0.f, 0.f};
#pragma unroll
                for (int ai = 0; ai < 2; ++ai)
#pragma unroll
                    for (int m = 0; m < 4; ++m) acc[ai][bj][m][n] += bv; }
        bool bad = st1.run(acc, u, wr, wc, fr, fq, lds, wid, lane) || poison != 0u;
        const float qnan = __builtin_nanf("");
#pragma unroll
        for (int ai = 0; ai < 2; ++ai)
#pragma unroll
            for (int m = 0; m < 4; ++m) { const int r = ai * HALF + wr * 64 + m * 16 + fr; const f32x2v sr = S[r]; const size_t off = (size_t)(u.pm * BM + r) * ldc + col0;
#pragma unroll
                for (int bj = 0; bj < 2; ++bj)
#pragma unroll
                    for (int n = 0; n < 2; ++n) { const f32x4 bs = *(const f32x4*)(base + off + bj * HALF + n * 16); acc[ai][bj][m][n] = bs + (acc[ai][bj][m][n] - sr.x) * sr.y; }
                asm volatile("" : "+v"(acc[ai][0][m][0]), "+v"(acc[ai][0][m][1]), "+v"(acc[ai][1][m][0]), "+v"(acc[ai][1][m][1]));
                if (m & 1) asm volatile("" ::: "memory"); }
        const bool bad1 = bad;
        bad = st2.run(acc, u, wr, wc, fr, fq, lds, wid, lane) || bad;
#pragma unroll
        for (int ai = 0; ai < 2; ++ai)
#pragma unroll
            for (int m = 0; m < 4; ++m) { const int r = ai * HALF + wr * 64 + m * 16 + fr; const f32x2v sr = S[r]; const size_t off = (size_t)(u.pm * BM + r) * ldc + col0;
#pragma unroll
                for (int bj = 0; bj < 2; ++bj)
#pragma unroll
                    for (int n = 0; n < 2; ++n) { const f32x4 x1 = acc[ai][bj][m][n]; *(f32x4*)(out + off + bj * HALF + n * 16) = bad1 ? (f32x4){qnan, qnan, qnan, qnan} : x1;
                        const f32x4 o = (x1 - sr.x) * sr.y; u32x2v w; w.x = cvt_pk_bf16(o[0], o[1]); w.y = cvt_pk_bf16(o[2], o[3]);
                        if (bad) { w.x = 0x7fc07fc0u; w.y = 0x7fc07fc0u; } *(u32x2v*)(xn + off + bj * HALF + n * 16) = w; }
                asm volatile("" ::: "memory"); }
    }
};

template <class Epi, class Sched, bool ALIGN_EPI = false, bool SP2 = false>
__device__ __forceinline__ void gemm_phase(PG8_LAS unsigned char* lds, const Gemm g, const Sched& S, const Epi& E) {
    int tid_o = threadIdx.x; asm volatile("" : "+v"(tid_o));
    const int tid = tid_o, wid = __builtin_amdgcn_readfirstlane(tid >> 6), lane = tid & 63, wr = wid >> 2, wc = wid & 3, fr = lane & 15, fq = lane >> 4;
    const int K = g.K, nt = K / BK;
    unsigned voffA[2], voffB[2];
#pragma unroll
    for (int i = 0; i < 2; ++i) { int R, C; stage_rc(tid * 16 + i * 8192, R, C); const int Rb = Epi::PERM ? ((R & ~31) + perm32(R & 31)) : R;
        voffA[i] = (unsigned)(R * K + C) * 2u; voffB[i] = (unsigned)(Rb * K + C) * 2u; }
    const size_t kstep = (size_t)(BK * 2);
    const size_t hstep = (size_t)HALF * K * 2;
    const size_t tstep = 2 * hstep;
    const unsigned ldsw = (unsigned)wid * 1024u;
    const int aoff = lds_byte(wr * 64 + fr, fq * 8), boff = lds_byte(wc * 32 + fr, fq * 8);
#define PG8_SA(b, h) (((b) * 2 + (h)) * HTB)
#define PG8_SB(b, h) ((4 + (b) * 2 + (h)) * HTB)
#define PG8_STAGE(bufoff, gbase, voff) do { _Pragma("unroll") for (int _i = 0; _i < 2; ++_i) \
        __builtin_amdgcn_global_load_lds((const unsigned*)((const char*)(gbase) + (voff)[_i]), (PG8_LAS unsigned*)(lds + (bufoff) + ldsw + _i * 8192), 16, 0, 0); } while (0)
#define PG8_LDA(dst, b, h) do { _Pragma("unroll") for (int m = 0; m < 4; ++m) _Pragma("unroll") for (int k = 0; k < 2; ++k) dst[m][k] = *(const PG8_LAS bf16x8*)(lds + PG8_SA(b, h) + aoff + m * 2048 + k * 1024); } while (0)
#define PG8_LDB(dst, b, h) do { _Pragma("unroll") for (int n = 0; n < 2; ++n) _Pragma("unroll") for (int k = 0; k < 2; ++k) dst[n][k] = *(const PG8_LAS bf16x8*)(lds + PG8_SB(b, h) + boff + n * 2048 + k * 1024); } while (0)
#define PG8_MMA(ai, bj, At, Bt) do { __builtin_amdgcn_s_setprio(1); _Pragma("unroll") for (int m = 0; m < 4; ++m) _Pragma("unroll") for (int n = 0; n < 2; ++n) _Pragma("unroll") for (int k = 0; k < 2; ++k) \
        acc[ai][bj][m][n] = __builtin_amdgcn_mfma_f32_16x16x32_bf16(Bt[n][k], At[m][k], acc[ai][bj][m][n], 0, 0, 0); __builtin_amdgcn_s_setprio(0); } while (0)
#define PG8_WAIT_V(n) asm volatile("s_waitcnt vmcnt(" #n ")" ::: "memory")
#define PG8_WAIT_L(n) asm volatile("s_waitcnt lgkmcnt(" #n ")" ::: "memory")
#define PG8_BAR __builtin_amdgcn_s_barrier()
#define PG8_SCHED __builtin_amdgcn_sched_barrier(0)
    Unit cur, nxt; int ui = 0;
    if (!S.next(0, cur)) return;
    f32x4 acc[2][2][4][2];
#pragma unroll
    for (int a = 0; a < 2; ++a)
#pragma unroll
        for (int b = 0; b < 2; ++b)
#pragma unroll
            for (int m = 0; m < 4; ++m)
#pragma unroll
                for (int n = 0; n < 2; ++n) acc[a][b][m][n] = (f32x4){0.f, 0.f, 0.f, 0.f};
    bf16x8 At[4][2], B0[2][2], B1[2][2];
    const char* cA = (const char*)g.A + (size_t)cur.pm * tstep; const char* cB = (const char*)g.Bt + (size_t)cur.pn * tstep;
    S.a_ready(cur);
    if constexpr (SP2) {
        PG8_STAGE(PG8_SB(0, 0), cB, voffB); PG8_STAGE(PG8_SB(0, 1), cB + hstep, voffB); PG8_STAGE(PG8_SA(0, 0), cA, voffA); PG8_STAGE(PG8_SA(0, 1), cA + hstep, voffA);
        if (wr == 1) PG8_BAR;
        PG8_WAIT_V(2); PG8_BAR;
        PG8_STAGE(PG8_SB(1, 0), cB + kstep, voffB); PG8_STAGE(PG8_SA(1, 0), cA + kstep, voffA); PG8_STAGE(PG8_SB(1, 1), cB + hstep + kstep, voffB);
        PG8_WAIT_V(6); PG8_BAR;
    } else {
        PG8_STAGE(PG8_SB(0, 0), cB, voffB); PG8_STAGE(PG8_SA(0, 0), cA, voffA); PG8_STAGE(PG8_SB(0, 1), cB + hstep, voffB); PG8_STAGE(PG8_SA(0, 1), cA + hstep, voffA);
        if (wr == 1) PG8_BAR;
        PG8_WAIT_V(4); PG8_BAR;
        PG8_STAGE(PG8_SB(1, 0), cB + kstep, voffB); PG8_STAGE(PG8_SA(1, 0), cA + kstep, voffA); PG8_STAGE(PG8_SB(1, 1), cB + hstep + kstep, voffB);
        PG8_WAIT_V(6); PG8_BAR;
    }
    for (;;) {
        const bool has_next = S.next(ui + 1, nxt);
        const char* nA = has_next ? (const char*)g.A + (size_t)nxt.pm * tstep : cA; const char* nB = has_next ? (const char*)g.Bt + (size_t)nxt.pn * tstep : cB;
        for (int t = 0; t < nt; t += 2) {
            const bool last = (t == nt - 2);
            const char* a1 = cA + (size_t)(t + 1) * kstep;
            const char* a2 = last ? nA : cA + (size_t)(t + 2) * kstep; const char* b2 = last ? nB : cB + (size_t)(t + 2) * kstep;
            const char* a3 = a2 + kstep; const char* b3 = b2 + kstep;
            if (last && has_next) S.a_ready(nxt);
            if constexpr (SP2) {
            PG8_LDB(B0, 0, 0); PG8_LDB(B1, 0, 1); PG8_SCHED; PG8_LDA(At, 0, 0); PG8_STAGE(PG8_SA(1, 1), a1 + hstep, voffA);
            PG8_WAIT_V(8); PG8_WAIT_L(0); PG8_BAR; PG8_MMA(0, 0, At, B0); PG8_MMA(0, 1, At, B1); PG8_BAR; PG8_SCHED;
            PG8_LDA(At, 0, 1); PG8_STAGE(PG8_SB(0, 0), b2, voffB); PG8_STAGE(PG8_SB(0, 1), b2 + hstep, voffB); PG8_STAGE(PG8_SA(0, 0), a2, voffA);
            PG8_WAIT_V(8); PG8_WAIT_L(0); PG8_BAR; PG8_MMA(1, 0, At, B0); PG8_MMA(1, 1, At, B1); PG8_BAR; PG8_SCHED;
            PG8_LDB(B0, 1, 0); PG8_LDB(B1, 1, 1); PG8_SCHED; PG8_LDA(At, 1, 0); PG8_STAGE(PG8_SA(0, 1), a2 + hstep, voffA);
            PG8_WAIT_V(8); PG8_WAIT_L(0); PG8_BAR; PG8_MMA(0, 0, At, B0); PG8_MMA(0, 1, At, B1); PG8_BAR; PG8_SCHED;
            PG8_LDA(At, 1, 1); PG8_STAGE(PG8_SB(1, 0), b3, voffB); PG8_STAGE(PG8_SB(1, 1), b3 + hstep, voffB); PG8_STAGE(PG8_SA(1, 0), a3, voffA);
            PG8_WAIT_V(8); PG8_WAIT_L(0); PG8_BAR; PG8_MMA(1, 0, At, B0); PG8_MMA(1, 1, At, B1); PG8_BAR; PG8_SCHED;
            } else {
            PG8_LDB(B0, 0, 0); PG8_SCHED; PG8_LDA(At, 0, 0); PG8_STAGE(PG8_SA(1, 1), a1 + hstep, voffA);
            PG8_WAIT_L(8); PG8_BAR; PG8_WAIT_L(0); PG8_MMA(0, 0, At, B0); PG8_BAR; PG8_SCHED;
            PG8_LDB(B1, 0, 1); PG8_STAGE(PG8_SB(0, 0), b2, voffB);
            PG8_BAR; PG8_WAIT_L(0); PG8_MMA(0, 1, At, B1); PG8_BAR;
            PG8_LDA(At, 0, 1); PG8_STAGE(PG8_SA(0, 0), a2, voffA);
            PG8_BAR; PG8_WAIT_L(0); PG8_MMA(1, 0, At, B0); PG8_BAR; PG8_SCHED;
            PG8_STAGE(PG8_SB(0, 1), b2 + hstep, voffB);
            PG8_WAIT_V(6); PG8_BAR; PG8_MMA(1, 1, At, B1); PG8_BAR;
            PG8_LDB(B0, 1, 0); PG8_SCHED; PG8_LDA(At, 1, 0); PG8_STAGE(PG8_SA(0, 1), a2 + hstep, voffA);
            PG8_WAIT_L(8); PG8_BAR; PG8_WAIT_L(0); PG8_MMA(0, 0, At, B0); PG8_BAR; PG8_SCHED;
            PG8_LDB(B1, 1, 1); PG8_STAGE(PG8_SB(1, 0), b3, voffB);
            PG8_BAR; PG8_WAIT_L(0); PG8_MMA(0, 1, At, B1); PG8_BAR;
            PG8_LDA(At, 1, 1); PG8_STAGE(PG8_SA(1, 0), a3, voffA);
            PG8_BAR; PG8_WAIT_L(0); PG8_MMA(1, 0, At, B0); PG8_BAR; PG8_SCHED;
            PG8_STAGE(PG8_SB(1, 1), b3 + hstep, voffB);
            PG8_WAIT_V(6); PG8_BAR; PG8_MMA(1, 1, At, B1); PG8_BAR;
            }
        }
        if constexpr (ALIGN_EPI) { if (wr == 0) PG8_BAR; }
        if constexpr (!Epi::AFTER_DRAIN) { E(acc, cur, wr, wc, fr, fq); S.done(cur); }
        if (!has_next) break;
#pragma unroll
        for (int a = 0; a < 2; ++a)
#pragma unroll
            for (int b = 0; b < 2; ++b)
#pragma unroll
                for (int m = 0; m < 4; ++m)
#pragma unroll
                    for (int n = 0; n < 2; ++n) acc[a][b][m][n] = (f32x4){0.f, 0.f, 0.f, 0.f};
        cur = nxt; cA = nA; cB = nB; ++ui;
        if constexpr (ALIGN_EPI) { if (wr == 1) PG8_BAR; }
    }
    PG8_WAIT_V(0);
    if constexpr (!ALIGN_EPI) { if (wr == 0) PG8_BAR; }
    PG8_BAR;
    if constexpr (Epi::AFTER_DRAIN) { E.fused(acc, cur, wr, wc, fr, fq, lds, wid, lane); S.done(cur); }
#undef PG8_SA
#undef PG8_SB
#undef PG8_STAGE
#undef PG8_LDA
#undef PG8_LDB
#undef PG8_MMA
#undef PG8_WAIT_V
#undef PG8_WAIT_L
#undef PG8_BAR
#undef PG8_SCHED
}
}

#define LAS __attribute__((address_space(3)))
typedef unsigned short bf16;
typedef unsigned v4u __attribute__((ext_vector_type(4)));
typedef unsigned v2u __attribute__((ext_vector_type(2)));
typedef float f32x4 __attribute__((ext_vector_type(4)));
typedef float f32x16 __attribute__((ext_vector_type(16)));
typedef short bf16x8 __attribute__((ext_vector_type(8)));
typedef short s16x4 __attribute__((ext_vector_type(4)));
typedef short v4i16_t __attribute__((ext_vector_type(4)));

constexpr int D_MODEL = 2048, BATCH = 4, SEQ = 4096, DEPTH = 4, MTOK = BATCH * SEQ;
constexpr int WIN = 8192, DFF = 5632;
constexpr int C_HQ = 0, C_HF = 1024, C_HB = 2048, C_HI = 3072, C_HG = 4096, C_DQ = 5120, C_DK = 6144, C_DV = 7168;
constexpr float EPS = 1e-6f, LOG2E = 1.4426950408889634f;
constexpr int NTHR = 512, NWAVES = 8;
constexpr int LDS_BYTES = 147456;

constexpr size_t MiB = 1u << 20;
constexpr size_t WS_WIN = 1 * MiB, WS_WOUT = 33 * MiB, WS_WGU = 41 * MiB, WS_WDN = 85 * MiB;
constexpr size_t WS_H = 108 * MiB;
constexpr size_t WS_PROJ = 172 * MiB;
constexpr size_t WS_MIX = 428 * MiB;
constexpr size_t WS_ST = 492 * MiB;
constexpr size_t WS_DEC = 620 * MiB;
constexpr size_t WS_ST2 = 624 * MiB;
constexpr size_t WS_SSP = 752 * MiB;
constexpr size_t WS_END = 756 * MiB;

struct Params {
    const float* x; const float* norm_mix_w; const float* w_in; const float* lb_logits; const float* onorm_w; const float* qn_w; const float* kn_w;
    const float* da_lambda; const float* subln_w; const float* w_out; const float* norm_ffn_w; const float* w_gate; const float* w_up; const float* w_down;
    float* out; unsigned char* ws;
};

__device__ __forceinline__ unsigned f2bf(float f) { unsigned u = __builtin_bit_cast(unsigned, f); return (u + 0x7fffu + ((u >> 16) & 1u)) >> 16; }
__device__ __forceinline__ unsigned pk2(float lo, float hi) { return f2bf(lo) | (f2bf(hi) << 16); }
typedef float f32x2 __attribute__((ext_vector_type(2)));
typedef __bf16 bf16x2_t __attribute__((ext_vector_type(2)));
__device__ __forceinline__ unsigned cvtpk(float lo, float hi) { f32x2 v = {lo, hi}; bf16x2_t b = __builtin_convertvector(v, bf16x2_t); return __builtin_bit_cast(unsigned, b); }
__device__ __forceinline__ float bf2f(unsigned short u) { return __uint_as_float(((unsigned)u) << 16); }
__device__ __forceinline__ float bflo(unsigned u) { return __uint_as_float(u << 16); }
__device__ __forceinline__ float bfhi(unsigned u) { return __uint_as_float(u & 0xffff0000u); }
__device__ __forceinline__ float wave_sum(float v) {
#pragma unroll
    for (int o = 1; o < 64; o <<= 1) v += __shfl_xor(v, o);
    return v;
}
__device__ __forceinline__ s16x4 vtr(const LAS unsigned char* p) { return __builtin_bit_cast(s16x4, __builtin_amdgcn_ds_read_tr16_b64_v4i16((LAS v4i16_t*)p)); }
#define MFMA32(a, b, c) __builtin_amdgcn_mfma_f32_32x32x16_bf16((a), (b), (c), 0, 0, 0)
__device__ __forceinline__ bf16x8 pack8(const f32x16& x, int s) {
    v4u p; p.x = pk2(x[8 * s + 0], x[8 * s + 1]); p.y = pk2(x[8 * s + 2], x[8 * s + 3]); p.z = pk2(x[8 * s + 4], x[8 * s + 5]); p.w = pk2(x[8 * s + 6], x[8 * s + 7]);
    return __builtin_bit_cast(bf16x8, p);
}

namespace pg8 {
constexpr int RS_OFF = STAGE_BYTES;
struct RowScaleOrder : StaticOrder {
    const float* rtab; PG8_LAS unsigned char* lds0; mutable int k;
    __device__ __forceinline__ void a_ready(const Unit& u) const {
        int t_ = threadIdx.x; asm volatile("" : "+v"(t_));
        if (t_ < 64) __builtin_amdgcn_global_load_lds((const unsigned*)(rtab + (size_t)u.pm * BM + 4 * t_), (PG8_LAS unsigned*)(lds0 + RS_OFF + (k & 1) * 1024), 16, 0, 0);
        ++k;
    }
};
struct EpiBf16Scale {
    static constexpr bool PERM = true, AFTER_DRAIN = false;
    bf16_t* O; int ldc; PG8_LAS unsigned char* lds0; mutable int k;
    __device__ __forceinline__ void operator()(const f32x4 (&acc)[2][2][4][2], const Unit& u, int wr, int wc, int fr, int fq) const {
        const PG8_LAS float* rs = (const PG8_LAS float*)(lds0 + RS_OFF + (k & 1) * 1024) + wr * 64 + fr; ++k;
        const int row0 = u.pm * BM + wr * 64 + fr;
        if (u.pn >= 20 && u.pn < 28) {
            const PG8_LAS f32x4* wq = (const PG8_LAS f32x4*)(lds0 + RS_OFF + 2048 + ((u.pn >= 24) ? 256 : 0) + 32 * fq);
            const f32x4 w00 = wq[0], w01 = wq[1], w10 = wq[8], w11 = wq[9];
            const int col0 = u.pn * BM + 64 * wc + 8 * fq;
#pragma unroll
            for (int ai = 0; ai < 2; ++ai)
#pragma unroll
                for (int m = 0; m < 4; ++m) { const float r = rs[ai * HALF + m * 16];
                    const f32x4 a0 = acc[ai][0][m][0] * r, a1 = acc[ai][0][m][1] * r, b0 = acc[ai][1][m][0] * r, b1 = acc[ai][1][m][1] * r;
                    float ss = ((a0[0] * a0[0] + a0[1] * a0[1]) + (a0[2] * a0[2] + a0[3] * a0[3])) + ((a1[0] * a1[0] + a1[1] * a1[1]) + (a1[2] * a1[2] + a1[3] * a1[3]))
                             + ((b0[0] * b0[0] + b0[1] * b0[1]) + (b0[2] * b0[2] + b0[3] * b0[3])) + ((b1[0] * b1[0] + b1[1] * b1[1]) + (b1[2] * b1[2] + b1[3] * b1[3]));
                    ss += __shfl_xor(ss, 16); ss += __shfl_xor(ss, 32);
                    const float rq = rsqrtf(ss * (1.f / 64.f) + 1e-6f);
                    const f32x4 p0 = a0 * rq * w00, p1 = a1 * rq * w01, q0 = b0 * rq * w10, q1 = b1 * rq * w11;
                    bf16_t* rowp = O + (size_t)(row0 + ai * HALF + m * 16) * ldc + col0;
                    u32x4 w; w.x = cvt_pk_bf16(p0[0], p0[1]); w.y = cvt_pk_bf16(p0[2], p0[3]); w.z = cvt_pk_bf16(p1[0], p1[1]); w.w = cvt_pk_bf16(p1[2], p1[3]);
                    *(u32x4*)rowp = w;
                    w.x = cvt_pk_bf16(q0[0], q0[1]); w.y = cvt_pk_bf16(q0[2], q0[3]); w.z = cvt_pk_bf16(q1[0], q1[1]); w.w = cvt_pk_bf16(q1[2], q1[3]);
                    *(u32x4*)(rowp + 32) = w; }
        } else {
            const int col0 = u.pn * BM + wc * 32 + 8 * fq;
#pragma unroll
            for (int ai = 0; ai < 2; ++ai)
#pragma unroll
                for (int m = 0; m < 4; ++m) { const float r = rs[ai * HALF + m * 16];
                    bf16_t* rowp = O + (size_t)(row0 + ai * HALF + m * 16) * ldc + col0;
#pragma unroll
                    for (int bj = 0; bj < 2; ++bj) { const f32x4 v0 = acc[ai][bj][m][0] * r, v1 = acc[ai][bj][m][1] * r;
                        u32x4 w; w.x = cvt_pk_bf16(v0[0], v0[1]); w.y = cvt_pk_bf16(v0[2], v0[3]); w.z = cvt_pk_bf16(v1[0], v1[1]); w.w = cvt_pk_bf16(v1[2], v1[3]);
                        *(u32x4*)(rowp + bj * HALF) = w; } }
        }
    }
};
struct EpiResF32 {
    static constexpr bool PERM = true, AFTER_DRAIN = false;
    float* out; int ldc; bf16_t* xb; float* ssp;
    __device__ __forceinline__ void operator()(const f32x4 (&acc)[2][2][4][2], const Unit& u, int wr, int wc, int fr, int fq) const {
        const int row0 = u.pm * BM + wr * 64 + fr, col0 = u.pn * BM + wc * 32 + 8 * fq;
#pragma unroll
        for (int ai = 0; ai < 2; ++ai)
#pragma unroll
            for (int m = 0; m < 4; ++m) { const int row = row0 + ai * HALF + m * 16; const size_t ro = (size_t)row * ldc + col0; float sq = 0.f;
#pragma unroll
                for (int bj = 0; bj < 2; ++bj) { const size_t o = ro + bj * HALF;
                    const u32x4 b = *(const u32x4*)(xb + o);
                    const f32x4 b0 = {__uint_as_float(b.x << 16), __uint_as_float(b.x & 0xffff0000u), __uint_as_float(b.y << 16), __uint_as_float(b.y & 0xffff0000u)};
                    const f32x4 b1 = {__uint_as_float(b.z << 16), __uint_as_float(b.z & 0xffff0000u), __uint_as_float(b.w << 16), __uint_as_float(b.w & 0xffff0000u)};
                    const f32x4 v0 = b0 + acc[ai][bj][m][0], v1 = b1 + acc[ai][bj][m][1];
                    if (out) { *(f32x4*)(out + o) = v0; *(f32x4*)(out + o + 4) = v1; }
                    else { u32x4 w; w.x = cvt_pk_bf16(v0[0], v0[1]); w.y = cvt_pk_bf16(v0[2], v0[3]); w.z = cvt_pk_bf16(v1[0], v1[1]); w.w = cvt_pk_bf16(v1[2], v1[3]); *(u32x4*)(xb + o) = w;
                           sq += ((v0[0] * v0[0] + v0[1] * v0[1]) + (v0[2] * v0[2] + v0[3] * v0[3])) + ((v1[0] * v1[0] + v1[1] * v1[1]) + (v1[2] * v1[2] + v1[3] * v1[3])); } }
                if (!out) { sq += __shfl_xor(sq, 16); sq += __shfl_xor(sq, 32); if (fq == 0) ssp[(size_t)row * 32 + u.pn * 4 + wc] = sq; } }
    }
};
struct EpiSwiGLU {
    static constexpr bool PERM = true, AFTER_DRAIN = false;
    bf16_t* O; int ldc; PG8_LAS unsigned char* lds0; mutable int k;
    __device__ __forceinline__ void operator()(const f32x4 (&acc)[2][2][4][2], const Unit& u, int wr, int wc, int fr, int fq) const {
        const PG8_LAS float* rs = (const PG8_LAS float*)(lds0 + RS_OFF + (k & 1) * 1024) + wr * 64 + fr; ++k;
        const int row0 = u.pm * BM + wr * 64 + fr, col0 = u.pn * HALF + wc * 32 + 8 * fq;
#pragma unroll
        for (int ai = 0; ai < 2; ++ai)
#pragma unroll
            for (int m = 0; m < 4; ++m) { const float rr = rs[ai * HALF + m * 16];
                bf16_t* rowp = O + (size_t)(row0 + ai * HALF + m * 16) * ldc + col0; float r[8];
#pragma unroll
                for (int n = 0; n < 2; ++n)
#pragma unroll
                    for (int j = 0; j < 4; ++j) { const float g = acc[ai][0][m][n][j] * rr, up = acc[ai][1][m][n][j] * rr; r[4 * n + j] = g * __builtin_amdgcn_rcpf(1.f + __expf(-g)) * up; }
                u32x4 w; w.x = cvt_pk_bf16(r[0], r[1]); w.y = cvt_pk_bf16(r[2], r[3]); w.z = cvt_pk_bf16(r[4], r[5]); w.w = cvt_pk_bf16(r[6], r[7]);
                *(u32x4*)rowp = w; }
    }
};
}

constexpr int TP = 65, TSCR = 64 * TP * 4;
struct CvItem { const float* W; bf16* WT; const float* kscale; int K, N, k0, n0, drow0, hi_skip; };
constexpr int CV_I_IN = (D_MODEL / 64) * (WIN / 64), CV_I_OUT = (D_MODEL / 64) * (D_MODEL / 64), CV_I_G = (D_MODEL / 64) * (DFF / 64), CV_I_DN = (DFF / 64) * (D_MODEL / 64);
constexpr int CV_NIT = CV_I_IN + CV_I_OUT + 2 * CV_I_G + CV_I_DN;
__device__ __forceinline__ CvItem cv_item(const Params& P, int l, int it) {
    bf16* WTin = (bf16*)(P.ws + WS_WIN); bf16* WTout = (bf16*)(P.ws + WS_WOUT); bf16* WTgu = (bf16*)(P.ws + WS_WGU); bf16* WTdn = (bf16*)(P.ws + WS_WDN);
    CvItem c; int r = it;
    if (r < CV_I_IN) { const int nb = WIN / 64, kb = r / nb, n0 = 64 * (r % nb); const bool qk = (n0 >= C_DQ && n0 < C_DV);
        c = CvItem{P.w_in + (size_t)l * D_MODEL * WIN, WTin, P.norm_mix_w + l * D_MODEL, D_MODEL, WIN, 64 * kb, n0, qk ? ((n0 & ~255) + 32 * ((n0 & 255) >> 6)) : n0, qk ? 96 : 0}; return c; } r -= CV_I_IN;
    if (r < CV_I_OUT) { const int nb = D_MODEL / 64, kb = r / nb, n0 = 64 * (r % nb); c = CvItem{P.w_out + (size_t)l * D_MODEL * D_MODEL, WTout, nullptr, D_MODEL, D_MODEL, 64 * kb, n0, n0, 0}; return c; } r -= CV_I_OUT;
    if (r < CV_I_G) { const int nb = DFF / 64, kb = r / nb, n0 = 64 * (r % nb); c = CvItem{P.w_gate + (size_t)l * D_MODEL * DFF, WTgu, P.norm_ffn_w + l * D_MODEL, D_MODEL, DFF, 64 * kb, n0, 256 * (n0 >> 7) + (n0 & 127), 0}; return c; } r -= CV_I_G;
    if (r < CV_I_G) { const int nb = DFF / 64, kb = r / nb, n0 = 64 * (r % nb); c = CvItem{P.w_up + (size_t)l * D_MODEL * DFF, WTgu, P.norm_ffn_w + l * D_MODEL, D_MODEL, DFF, 64 * kb, n0, 256 * (n0 >> 7) + 128 + (n0 & 127), 0}; return c; } r -= CV_I_G;
    { const int nb = D_MODEL / 64, kb = r / nb, n0 = 64 * (r % nb); c = CvItem{P.w_down + (size_t)l * DFF * D_MODEL, WTdn, nullptr, DFF, D_MODEL, 64 * kb, n0, n0, 0}; }
    return c;
}
__device__ __forceinline__ void cv_load(const CvItem& c, int lane, f32x4 (&v)[16], float (&ks)[16]) {
    if (c.kscale) {
#pragma unroll
        for (int i = 0; i < 16; ++i) ks[i] = c.kscale[c.k0 + (lane >> 4) + 4 * i];
    } else {
#pragma unroll
        for (int i = 0; i < 16; ++i) ks[i] = 1.f;
    }
    const float* src = c.W + (size_t)(c.k0 + (lane >> 4)) * c.N + c.n0 + 4 * (lane & 15);
#pragma unroll
    for (int i = 0; i < 16; ++i) v[i] = *(const f32x4*)(src + (size_t)(4 * i) * c.N);
}
__device__ __forceinline__ void cv_finish(const CvItem& c, int lane, f32x4 (&v)[16], const float (&ks)[16], LAS float* scr) {
#pragma unroll
    for (int i = 0; i < 16; ++i) v[i] = v[i] * ks[i];
#pragma unroll
    for (int i = 0; i < 16; ++i) { LAS float* d = scr + ((lane >> 4) + 4 * i) * TP + 4 * (lane & 15); d[0] = v[i].x; d[1] = v[i].y; d[2] = v[i].z; d[3] = v[i].w; }
    asm volatile("s_waitcnt lgkmcnt(0)" ::: "memory");
    const int cc = lane & 7;
#pragma unroll
    for (int j = 0; j < 8; ++j) { const int n = (lane >> 3) + 8 * j; const LAS float* s = scr + (8 * cc) * TP + n;
        v4u o; o.x = cvtpk(s[0 * TP], s[1 * TP]); o.y = cvtpk(s[2 * TP], s[3 * TP]); o.z = cvtpk(s[4 * TP], s[5 * TP]); o.w = cvtpk(s[6 * TP], s[7 * TP]);
        *(v4u*)(c.WT + (size_t)(c.drow0 + n + ((j >= 4) ? c.hi_skip : 0)) * c.K + c.k0 + 8 * cc) = o; }
    asm volatile("s_waitcnt lgkmcnt(0)" ::: "memory");
}
__device__ __forceinline__ void convert_weights(const Params& P, int l, LAS unsigned char* lds, int gw, int ngw, int wave, int lane) {
    LAS float* scr = (LAS float*)(lds + wave * TSCR);
    if (gw >= CV_NIT) return;
    f32x4 va[16], vb[16]; float ka[16], kb[16];
    CvItem ca = cv_item(P, l, gw), cb = ca;
    cv_load(ca, lane, va, ka);
    for (int it = gw; it < CV_NIT; it += 2 * ngw) {
        const bool hb = (it + ngw < CV_NIT);
        if (hb) { cb = cv_item(P, l, it + ngw); cv_load(cb, lane, vb, kb); }
        cv_finish(ca, lane, va, ka, scr);
        if (!hb) break;
        const bool ha = (it + 2 * ngw < CV_NIT);
        if (ha) { ca = cv_item(P, l, it + 2 * ngw); cv_load(ca, lane, va, ka); }
        cv_finish(cb, lane, vb, kb, scr);
        if (!ha) break;
    }
}
__device__ __forceinline__ void x_to_bf16_rows(const float* X, bf16* XB, float* rtab, int gw, int ngw, int lane) {
    for (int m = gw; m < MTOK; m += ngw) {
        const f32x4* xr = (const f32x4*)(X + (size_t)m * D_MODEL) + lane;
        f32x4 v[8]; float s = 0.f;
#pragma unroll
        for (int j = 0; j < 8; ++j) { v[j] = xr[64 * j]; s += (v[j].x * v[j].x + v[j].y * v[j].y) + (v[j].z * v[j].z + v[j].w * v[j].w); }
        s = wave_sum(s);
        if (lane == 0) rtab[m] = rsqrtf(s * (1.f / D_MODEL) + EPS);
        v2u* o8 = (v2u*)(XB + (size_t)m * D_MODEL) + lane;
#pragma unroll
        for (int j = 0; j < 8; ++j) { v2u o; o.x = cvtpk(v[j].x, v[j].y); o.y = cvtpk(v[j].z, v[j].w); o8[64 * j] = o; }
    }
}
__device__ __forceinline__ void rstd_rows(const float* ssp, float* rtab, int gtid, int ngt) {
    for (int m = gtid; m < MTOK; m += ngt) {
        const f32x4* p = (const f32x4*)(ssp + (size_t)m * 32); float t = 0.f;
#pragma unroll
        for (int k = 0; k < 8; ++k) { const f32x4 v = p[k]; t += (v[0] + v[1]) + (v[2] + v[3]); }
        rtab[m] = rsqrtf(t * (1.f / D_MODEL) + EPS);
    }
}
__device__ __forceinline__ void qknorm_rows(bf16* PROJ, const float* qn_w, const float* kn_w, int gw, int ngw, int lane) {
    const int d0 = 8 * (lane & 7);
    float wq[8], wk[8];
#pragma unroll
    for (int j = 0; j < 8; ++j) { wq[j] = qn_w[d0 + j] * (0.125f * LOG2E); wk[j] = kn_w[d0 + j]; }
    for (int m = gw; m < MTOK; m += ngw) {
#pragma unroll
        for (int it = 0; it < 4; ++it) {
            bf16* p = PROJ + (size_t)m * WIN + C_DQ + it * 512 + 8 * lane;
            const v4u raw = *(const v4u*)p;
            float v[8] = {bflo(raw.x), bfhi(raw.x), bflo(raw.y), bfhi(raw.y), bflo(raw.z), bfhi(raw.z), bflo(raw.w), bfhi(raw.w)};
            float s = 0.f;
#pragma unroll
            for (int j = 0; j < 8; ++j) s += v[j] * v[j];
            s += __shfl_xor(s, 1); s += __shfl_xor(s, 2); s += __shfl_xor(s, 4);
            const float r = rsqrtf(s * (1.f / 64.f) + EPS);
            v4u o;
            if (it < 2) { o.x = pk2(v[0] * r * wq[0], v[1] * r * wq[1]); o.y = pk2(v[2] * r * wq[2], v[3] * r * wq[3]); o.z = pk2(v[4] * r * wq[4], v[5] * r * wq[5]); o.w = pk2(v[6] * r * wq[6], v[7] * r * wq[7]); }
            else        { o.x = pk2(v[0] * r * wk[0], v[1] * r * wk[1]); o.y = pk2(v[2] * r * wk[2], v[3] * r * wk[3]); o.z = pk2(v[4] * r * wk[4], v[5] * r * wk[5]); o.w = pk2(v[6] * r * wk[6], v[7] * r * wk[7]); }
            *(v4u*)p = o;
        }
    }
}

__device__ __forceinline__ bf16x8 pack8c(const f32x16& x, int s) {
    v4u p; p.x = cvtpk(x[8 * s + 0], x[8 * s + 1]); p.y = cvtpk(x[8 * s + 2], x[8 * s + 3]); p.z = cvtpk(x[8 * s + 4], x[8 * s + 5]); p.w = cvtpk(x[8 * s + 6], x[8 * s + 7]);
    return __builtin_bit_cast(bf16x8, p);
}
constexpr int K_PITCH = 272, K_TILE = 64 * K_PITCH, V_PITCH = 320, V_TILE = 64 * V_PITCH;
constexpr float ATT_THR = 60.f;
__device__ __forceinline__ void attn_half_a(const LAS unsigned char* kb, const LAS unsigned char* qs, int t, int t_diag, int qpos, int hh, float cs, float csq, float csh,
                                            float& m_ref, float& l_run, f32x16 (&o)[4], f32x16& s0, f32x16& s1) {
    bf16x8 qf[4];
#pragma unroll
    for (int ks = 0; ks < 4; ++ks) qf[ks] = *(const LAS bf16x8*)(qs + ks * 1024);
    const float tb = cs * (float)(64 * t);
    const float cval = (t < t_diag) ? (tb + csh - m_ref) : (t > t_diag) ? (2.f * csq - tb - csh - m_ref) : (csq - m_ref);
    { bf16x8 a0 = *(const LAS bf16x8*)(kb), a1 = *(const LAS bf16x8*)(kb + 32 * K_PITCH);
      bf16x8 b0 = *(const LAS bf16x8*)(kb + 32), b1 = *(const LAS bf16x8*)(kb + 32 * K_PITCH + 32);
      f32x16 cinit;
#pragma unroll
      for (int i = 0; i < 16; ++i) cinit[i] = cval;
      s0 = MFMA32(a0, qf[0], cinit); s1 = MFMA32(a1, qf[0], cinit);
      a0 = *(const LAS bf16x8*)(kb + 64); a1 = *(const LAS bf16x8*)(kb + 32 * K_PITCH + 64);
      s0 = MFMA32(b0, qf[1], s0); s1 = MFMA32(b1, qf[1], s1);
      b0 = *(const LAS bf16x8*)(kb + 96); b1 = *(const LAS bf16x8*)(kb + 32 * K_PITCH + 96);
      s0 = MFMA32(a0, qf[2], s0); s1 = MFMA32(a1, qf[2], s1);
      s0 = MFMA32(b0, qf[3], s0); s1 = MFMA32(b1, qf[3], s1); }
    if (t != t_diag) {
        const float sg = (t < t_diag) ? cs : -cs;
#pragma unroll
        for (int i = 0; i < 16; ++i) { float a_ = __builtin_fmaf(sg, (float)((i & 3) + 8 * (i >> 2)), s0[i]), b_ = __builtin_fmaf(sg, (float)((i & 3) + 8 * (i >> 2) + 32), s1[i]);
            asm volatile("" : "+v"(a_)); asm volatile("" : "+v"(b_)); s0[i] = a_; s1[i] = b_; }
    } else {
        const float dq = (float)(qpos - 64 * t - 4 * hh);
#pragma unroll
        for (int i = 0; i < 16; ++i) { const float d0 = dq - (float)((i & 3) + 8 * (i >> 2));
            s0[i] = __builtin_fmaf(-cs, __builtin_fabsf(d0), s0[i]); s1[i] = __builtin_fmaf(-cs, __builtin_fabsf(d0 - 32.f), s1[i]); }
    }
    float mxa = __builtin_fmaxf(__builtin_fmaxf(s0[0], s0[1]), s1[0]), mxb = __builtin_fmaxf(__builtin_fmaxf(s0[2], s0[3]), s1[1]);
    mxa = __builtin_fmaxf(__builtin_fmaxf(mxa, s1[2]), s1[3]);
#pragma unroll
    for (int i = 4; i < 16; i += 4) { mxa = __builtin_fmaxf(__builtin_fmaxf(mxa, s0[i]), s0[i + 1]); mxb = __builtin_fmaxf(__builtin_fmaxf(mxb, s0[i + 2]), s0[i + 3]);
        mxa = __builtin_fmaxf(__builtin_fmaxf(mxa, s1[i]), s1[i + 1]); mxb = __builtin_fmaxf(__builtin_fmaxf(mxb, s1[i + 2]), s1[i + 3]); }
    float mx = __builtin_fmaxf(mxa, mxb);
    { auto rr = __builtin_amdgcn_permlane32_swap(__float_as_uint(mx), __float_as_uint(mx), false, false); mx = __builtin_fmaxf(__uint_as_float(rr[0]), __uint_as_float(rr[1])); }
    if (__any(mx > ATT_THR)) {
        const float dl = __builtin_fmaxf(mx, 0.f);
        m_ref += dl;
        const float alpha = __builtin_amdgcn_exp2f(-dl);
        l_run *= alpha;
#pragma unroll
        for (int i = 0; i < 16; ++i) { s0[i] -= dl; s1[i] -= dl; }
#pragma unroll
        for (int e = 0; e < 4; ++e)
#pragma unroll
            for (int i = 0; i < 16; ++i) o[e][i] *= alpha;
    }
}
__device__ __forceinline__ void attn_half_b(const LAS unsigned char* vb, const f32x16& s0, const f32x16& s1, float& l_run, f32x16 (&o)[4]) {
    float rs[4];
#pragma unroll
    for (int ks = 0; ks < 4; ++ks) {
        s16x4 lo[4], hi[4];
        const int r1 = (32 * (ks >> 1) + 16 * (ks & 1)) * V_PITCH;
#pragma unroll
        for (int e = 0; e < 4; ++e) { lo[e] = vtr(vb + r1 + 64 * e); hi[e] = vtr(vb + r1 + 8 * V_PITCH + 64 * e); }
        float p[8];
#pragma unroll
        for (int j = 0; j < 8; ++j) p[j] = __builtin_amdgcn_exp2f((ks < 2) ? s0[8 * (ks & 1) + j] : s1[8 * (ks & 1) + j]);
        { float t0 = p[0] + p[1], t1 = p[2] + p[3], t2 = p[4] + p[5], t3 = p[6] + p[7];
          asm volatile("" : "+v"(t0)); asm volatile("" : "+v"(t1)); asm volatile("" : "+v"(t2)); asm volatile("" : "+v"(t3));
          float u0 = t0 + t1, u1 = t2 + t3; asm volatile("" : "+v"(u0)); asm volatile("" : "+v"(u1)); rs[ks] = u0 + u1; }
        v4u pw; pw.x = cvtpk(p[0], p[1]); pw.y = cvtpk(p[2], p[3]); pw.z = cvtpk(p[4], p[5]); pw.w = cvtpk(p[6], p[7]);
        const bf16x8 pf = __builtin_bit_cast(bf16x8, pw);
#pragma unroll
        for (int e = 0; e < 4; ++e) { const bf16x8 vf = __builtin_shufflevector(lo[e], hi[e], 0, 1, 2, 3, 4, 5, 6, 7); o[e] = MFMA32(vf, pf, o[e]); }
    }
    l_run += (rs[0] + rs[1]) + (rs[2] + rs[3]);
}
__device__ __forceinline__ void attn_unit(const Params& P, int l, int b, int h, int qb, float lam, float oscale, float zbound, LAS unsigned char* lds) {
    int tid_o = threadIdx.x; asm volatile("" : "+v"(tid_o));
    const int tid = tid_o, lane = tid & 63, r32 = lane & 31, hh = lane >> 5;
    const int wid = __builtin_amdgcn_readfirstlane(tid >> 6), map = wid >> 2, wq = wid & 3;
    const size_t rowbase = (size_t)b * SEQ;
    const int q0 = qb * 128 + wq * 32;
    const bf16* PROJ = (const bf16*)(P.ws + WS_PROJ);
    LAS unsigned char* qs = lds + 2 * K_TILE + 2 * V_TILE + wid * 4096 + lane * 16;
    { const bf16* qp = PROJ + (rowbase + q0 + r32) * WIN + C_DQ + h * 128 + map * 64 + hh * 8;
#pragma unroll
      for (int ks = 0; ks < 4; ++ks) *(LAS bf16x8*)(qs + ks * 1024) = *(const bf16x8*)(qp + 16 * ks); }
    const float cs = exp2f(-(float)(h + 1)) * LOG2E;
    f32x16 o[4];
#pragma unroll
    for (int e = 0; e < 4; ++e)
#pragma unroll
        for (int i = 0; i < 16; ++i) o[e][i] = 0.f;
    float m_ref = 0.f, l_run = 0.f;
    LAS unsigned char* sK = lds; LAS unsigned char* sV = lds + 2 * K_TILE;
    const int prow = tid >> 4, pc = tid & 15;
    const bf16* kg = PROJ + (rowbase + prow) * WIN + C_DK + h * 128 + pc * 8;
    const bf16* vg = PROJ + (rowbase + prow) * WIN + C_DV + h * 128 + pc * 8;
    const int soffk = prow * K_PITCH + pc * 16, soffv = prow * V_PITCH + pc * 16;
    int t_lo = 0, t_hi = SEQ / 64 - 1;
    { const float dmaxf = zbound * exp2f((float)(h + 1));
      if (dmaxf < (float)SEQ) { const int dmax = (int)dmaxf + 1; const int Q0 = qb * 128; t_lo = max(0, (Q0 - dmax) >> 6); t_hi = min(SEQ / 64 - 1, (Q0 + 127 + dmax) >> 6); } }
    t_lo = __builtin_amdgcn_readfirstlane(t_lo); t_hi = __builtin_amdgcn_readfirstlane(t_hi);
    v4u kr[2], vr[2];
#pragma unroll
    for (int i = 0; i < 2; ++i) { kr[i] = *(const v4u*)(kg + (size_t)(64 * t_lo + 32 * i) * WIN); vr[i] = *(const v4u*)(vg + (size_t)(64 * t_lo + 32 * i) * WIN); }
    const int buf0 = t_lo & 1;
#pragma unroll
    for (int i = 0; i < 2; ++i) { *(LAS v4u*)(sK + buf0 * K_TILE + soffk + i * 32 * K_PITCH) = kr[i]; *(LAS v4u*)(sV + buf0 * V_TILE + soffv + i * 32 * V_PITCH) = vr[i]; }
    __syncthreads();
    const int qpos = q0 + r32;
    const float csq = cs * (float)qpos, csh = cs * (float)(4 * hh);
    const int t_diag = q0 >> 6;
    const int vlane = ((lane & 15) >> 2) * V_PITCH + (16 * ((lane >> 4) & 1) + 4 * (lane & 3)) * 2;
    const int NT = t_hi - t_lo + 1;
    f32x16 s0, s1;
#pragma unroll
    for (int i = 0; i < 16; ++i) { s0[i] = -200.f; s1[i] = -200.f; }
    const LAS unsigned char* kb0 = sK + r32 * K_PITCH + (map * 64 + hh * 8) * 2;
    const LAS unsigned char* vb0 = sV + vlane + 4 * hh * V_PITCH;
#define ATT_LOAD(i_) do { if ((i_) + 1 < NT) { const int tn_ = t_lo + (i_) + 1; _Pragma("unroll") for (int q_ = 0; q_ < 2; ++q_) { \
        kr[q_] = *(const v4u*)(kg + (size_t)(64 * tn_ + 32 * q_) * WIN); vr[q_] = *(const v4u*)(vg + (size_t)(64 * tn_ + 32 * q_) * WIN); } } } while (0)
#define ATT_STORE(i_) do { if ((i_) + 1 < NT) { const int nb_ = (t_lo + (i_) + 1) & 1; _Pragma("unroll") for (int q_ = 0; q_ < 2; ++q_) { \
        *(LAS v4u*)(sK + nb_ * K_TILE + soffk + q_ * 32 * K_PITCH) = kr[q_]; *(LAS v4u*)(sV + nb_ * V_TILE + soffv + q_ * 32 * V_PITCH) = vr[q_]; } } } while (0)
    if (map == 0) {
        for (int i = 0; i < NT; ++i) {
            const int t = t_lo + i, buf = t & 1;
            ATT_LOAD(i);
            attn_half_a(kb0 + buf * K_TILE, qs, t, t_diag, qpos, hh, cs, csq, csh, m_ref, l_run, o, s0, s1);
            __syncthreads();
            attn_half_b(vb0 + buf * V_TILE, s0, s1, l_run, o);
            ATT_STORE(i);
            __syncthreads();
        }
        __syncthreads();
    } else {
        for (int i = 0; i < NT; ++i) {
            const int t = t_lo + i, buf = t & 1, pbuf = (i == 0) ? buf : (buf ^ 1);
            ATT_LOAD(i);
            attn_half_b(vb0 + pbuf * V_TILE, s0, s1, l_run, o);
            __syncthreads();
            attn_half_a(kb0 + buf * K_TILE, qs, t, t_diag, qpos, hh, cs, csq, csh, m_ref, l_run, o, s0, s1);
            ATT_STORE(i);
            __syncthreads();
        }
        attn_half_b(vb0 + ((t_lo + NT - 1) & 1) * V_TILE, s0, s1, l_run, o);
        __syncthreads();
    }
#undef ATT_LOAD
#undef ATT_STORE
    const float l_tot = l_run + __shfl_xor(l_run, 32);
    const float inv = 1.f / l_tot;
    LAS float* X = (LAS float*)lds;
    if (map == 1) {
#pragma unroll
        for (int e = 0; e < 4; ++e)
#pragma unroll
            for (int i = 0; i < 16; ++i) X[(wq * 64 + e * 16 + i) * 64 + lane] = o[e][i] * inv;
    }
    __syncthreads();
    if (map == 0) {
        float ss = 0.f;
#pragma unroll
        for (int e = 0; e < 4; ++e)
#pragma unroll
            for (int i = 0; i < 16; ++i) { const float v = o[e][i] * inv - lam * X[(wq * 64 + e * 16 + i) * 64 + lane]; o[e][i] = v; ss += v * v; }
        ss += __shfl_xor(ss, 32);
        const float r = rsqrtf(ss * (1.f / 128.f) + EPS) * oscale;
        bf16* MIX = (bf16*)(P.ws + WS_MIX) + (rowbase + q0 + r32) * D_MODEL + 1024 + h * 128;
        const float* sw = P.subln_w + l * 128;
#pragma unroll
        for (int e = 0; e < 4; ++e)
#pragma unroll
            for (int g = 0; g < 4; ++g) { const int ec = 32 * e + 8 * g + 4 * hh; const f32x4 w = *(const f32x4*)(sw + ec);
                v2u ov; ov.x = cvtpk(o[e][4 * g] * r * w.x, o[e][4 * g + 1] * r * w.y); ov.y = cvtpk(o[e][4 * g + 2] * r * w.z, o[e][4 * g + 3] * r * w.w);
                *(v2u*)(MIX + ec) = ov; }
    }
    __syncthreads();
}

constexpr int HP = 136, HTILE = 64 * HP * 2;
constexpr int KTP = 72;
__device__ __forceinline__ void lower_bound(const Params& P, int l, int dir, int col, float& lbm, float& oml) {
    const float* lg = P.lb_logits + (size_t)dir * DEPTH * 1024 + col;
    const float a0 = lg[0], a1 = lg[1024], a2 = lg[2048], a3 = lg[3072];
    const float mx = fmaxf(fmaxf(a0, a1), fmaxf(a2, a3));
    const float e0 = __expf(a0 - mx), e1 = __expf(a1 - mx), e2 = __expf(a2 - mx), e3 = __expf(a3 - mx);
    const float inv = 1.f / (e0 + e1 + e2 + e3);
    float lb = 0.f;
    if (l >= 1) lb += e1 * inv; if (l >= 2) lb += e2 * inv; if (l >= 3) lb += e3 * inv;
    lb = fminf(fmaxf(lb, 0.f), 1.0f - 1e-6f);
    lbm = fmaxf(lb, 1e-30f); oml = 1.f - lb;
}
__device__ __forceinline__ void hg_local_scan(const LAS unsigned short* zp, float lbm, float oml, int dir, float (&lf)[32], float (&kk)[32]) {
#pragma unroll
    for (int i = 0; i < 32; ++i) { const float z = bf2f(zp[i * HP]); const float sg = __builtin_amdgcn_rcpf(1.f + __expf(-z)); const float f = lbm + oml * sg; lf[i] = __logf(f); kk[i] = 1.f - f; }
    if (dir == 0) {
#pragma unroll
        for (int i = 1; i < 32; ++i) lf[i] += lf[i - 1];
    } else {
#pragma unroll
        for (int i = 30; i >= 0; --i) lf[i] += lf[i + 1];
    }
}
__device__ __forceinline__ void hg_load_tile(const bf16* PROJ, size_t row0, int col0, LAS unsigned char* dst, int tid) {
#pragma unroll
    for (int i = 0; i < 2; ++i) { const int p = tid + 512 * i, row = p >> 4, c = p & 15;
        *(LAS v4u*)(dst + row * (HP * 2) + c * 16) = *(const v4u*)(PROJ + (row0 + row) * WIN + col0 + c * 8); }
}
__device__ __forceinline__ void hg1_unit(const Params& P, int l, int bh, int c, LAS unsigned char* lds) {
    int tid_o = threadIdx.x; asm volatile("" : "+v"(tid_o));
    const int tid = tid_o, lane = tid & 63, r32 = lane & 31, hh = lane >> 5;
    const int wid = __builtin_amdgcn_readfirstlane(tid >> 6);
    const int b = bh >> 3, h = bh & 7;
    const size_t row0 = (size_t)b * SEQ + 64 * c;
    const bf16* PROJ = (const bf16*)(P.ws + WS_PROJ);
    LAS unsigned char* sV = lds; LAS unsigned char* sKT = lds + HTILE;
    LAS unsigned char* sZ = lds + HTILE + 2 * 128 * KTP * 2;
    hg_load_tile(PROJ, row0, C_HI + h * 128, sV, tid);
    hg_load_tile(PROJ, row0, C_HF + h * 128, sZ, tid);
    hg_load_tile(PROJ, row0, C_HB + h * 128, sZ + HTILE, tid);
    __syncthreads();
    {
        const int dir = tid >> 8, d = (tid >> 1) & 127, half = tid & 1;
        float lbm, oml; lower_bound(P, l, dir, h * 128 + d, lbm, oml);
        float lf[32], kk[32];
        hg_local_scan((const LAS unsigned short*)(sZ + dir * HTILE) + (32 * half) * HP + d, lbm, oml, dir, lf, kk);
        const float tot = dir ? lf[0] : lf[31];
        const float other = __shfl_xor(tot, 1);
        const bool far = dir ? (half == 0) : (half == 1);
        const float alast = tot + other, addfull = far ? other : 0.f;
        LAS unsigned char* dst = sKT + ((dir * 128 + d) * KTP + 32 * half) * 2;
#pragma unroll
        for (int g = 0; g < 4; ++g) { float kv[8];
#pragma unroll
            for (int j = 0; j < 8; ++j) kv[j] = kk[8 * g + j] * __expf(alast - (lf[8 * g + j] + addfull));
            v4u o; o.x = cvtpk(kv[0], kv[1]); o.y = cvtpk(kv[2], kv[3]); o.z = cvtpk(kv[4], kv[5]); o.w = cvtpk(kv[6], kv[7]);
            *(LAS v4u*)(dst + 16 * g) = o; }
        if (half == 0) ((float*)(P.ws + WS_DEC))[((size_t)(dir * 32 + bh) * 64 + c) * 128 + d] = __expf(alast);
    }
    __syncthreads();
    {
        const int dir = wid >> 2, db = wid & 3;
        bf16x8 af[4];
#pragma unroll
        for (int ks = 0; ks < 4; ++ks) af[ks] = *(const LAS bf16x8*)(sKT + ((dir * 128 + 32 * db + r32) * KTP + 16 * ks + 8 * hh) * 2);
        __syncthreads();
        const int vlane = ((lane & 15) >> 2) * (HP * 2) + (16 * ((lane >> 4) & 1) + 4 * (lane & 3)) * 2;
#pragma unroll
        for (int eb = 0; eb < 4; ++eb) {
            f32x16 acc;
#pragma unroll
            for (int i = 0; i < 16; ++i) acc[i] = 0.f;
#pragma unroll
            for (int ks = 0; ks < 4; ++ks) {
                const LAS unsigned char* a = sV + (16 * ks + 8 * hh) * (HP * 2) + 64 * eb + vlane;
                const s16x4 lo = vtr(a), hi = vtr(a + 4 * (HP * 2));
                const bf16x8 vf = __builtin_shufflevector(lo, hi, 0, 1, 2, 3, 4, 5, 6, 7);
                acc = MFMA32(af[ks], vf, acc);
            }
            LAS unsigned char* dst = sKT + ((dir * 128 + 32 * eb + r32) * HP + 32 * db + 4 * hh) * 2;
#pragma unroll
            for (int g = 0; g < 4; ++g) { v2u ov; ov.x = cvtpk(acc[4 * g], acc[4 * g + 1]); ov.y = cvtpk(acc[4 * g + 2], acc[4 * g + 3]); *(LAS v2u*)(dst + 16 * g) = ov; }
        }
    }
    __syncthreads();
    {
        bf16* ST = (bf16*)(P.ws + WS_ST);
#pragma unroll
        for (int i = 0; i < 8; ++i) { const int p = tid + 512 * i, dirp = p >> 11, rem = p & 2047, e = rem >> 4, c16 = rem & 15;
            const v4u v = *(const LAS v4u*)(sKT + ((dirp * 128 + e) * HP) * 2 + c16 * 16);
            *(v4u*)(ST + ((size_t)(dirp * 32 + bh) * 64 + c) * 16384 + e * 128 + c16 * 8) = v; }
    }
    __syncthreads();
}
template <int STEP> __device__ __forceinline__ void hg2_chain(const bf16* __restrict__ u0, bf16* __restrict__ s0, const LAS float* dec0) {
    float S[8];
#pragma unroll
    for (int j = 0; j < 8; ++j) S[j] = 0.f;
    for (int k0 = 0; k0 < 64; k0 += 8) {
        v4u u[8];
#pragma unroll
        for (int k = 0; k < 8; ++k) { const long c = (long)STEP * (k0 + k); u[k] = *(const v4u*)(u0 + c * 16384); }
#pragma unroll
        for (int k = 0; k < 8; ++k) { const int c = STEP * (k0 + k);
            const f32x4 d0 = *(const LAS f32x4*)(dec0 + c * 128), d1 = *(const LAS f32x4*)(dec0 + c * 128 + 4);
            v4u o; o.x = cvtpk(S[0], S[1]); o.y = cvtpk(S[2], S[3]); o.z = cvtpk(S[4], S[5]); o.w = cvtpk(S[6], S[7]);
            *(v4u*)(s0 + (long)c * 16384) = o;
            S[0] = d0.x * S[0] + bflo(u[k].x); S[1] = d0.y * S[1] + bfhi(u[k].x); S[2] = d0.z * S[2] + bflo(u[k].y); S[3] = d0.w * S[3] + bfhi(u[k].y);
            S[4] = d1.x * S[4] + bflo(u[k].z); S[5] = d1.y * S[5] + bfhi(u[k].z); S[6] = d1.z * S[6] + bflo(u[k].w); S[7] = d1.w * S[7] + bfhi(u[k].w); }
    }
}
__device__ __forceinline__ void hg2_scan(const Params& P, int bxi, int G, int tid, LAS unsigned char* lds) {
    LAS float* sdec = (LAS float*)lds;
    for (int wi = bxi; wi < 256; wi += G) {
        const int stream = wi >> 2, v16 = (wi & 3) * 512 + tid, dir = stream >> 5;
        { const f32x4* src = (const f32x4*)((const float*)(P.ws + WS_DEC) + (size_t)stream * 64 * 128);
#pragma unroll
          for (int i = 0; i < 4; ++i) ((LAS f32x4*)sdec)[tid + 512 * i] = src[tid + 512 * i]; }
        __syncthreads();
        const size_t eo = (size_t)stream * 64 * 16384 + v16 * 8;
        const bf16* ub = (const bf16*)(P.ws + WS_ST) + eo; bf16* sb = (bf16*)(P.ws + WS_ST2) + eo;
        const LAS float* dec = sdec + (v16 & 15) * 8;
        if (dir == 0) hg2_chain<1>(ub, sb, dec);
        else hg2_chain<-1>(ub + (size_t)63 * 16384, sb + (size_t)63 * 16384, dec + 63 * 128);
        __syncthreads();
    }
}
__device__ __forceinline__ void hg3_load_tiles(const Params& P, int bh, int c, int tid, v4u (&tl)[4][2]) {
    const bf16* PROJ = (const bf16*)(P.ws + WS_PROJ);
    const int b = bh >> 3, h = bh & 7; const size_t row0 = (size_t)b * SEQ + 64 * c;
    const int cols[4] = {C_HI, C_HF, C_HB, C_HQ};
#pragma unroll
    for (int q = 0; q < 4; ++q)
#pragma unroll
        for (int i = 0; i < 2; ++i) { const int p = tid + 512 * i, row = p >> 4, cc = p & 15; tl[q][i] = *(const v4u*)(PROJ + (row0 + row) * WIN + cols[q] + h * 128 + cc * 8); }
}
__device__ __forceinline__ void hg3_unit(const Params& P, int l, int bh, int c, int nbh, int nc, v4u (&tl)[4][2], LAS unsigned char* lds) {
    int tid_o = threadIdx.x; asm volatile("" : "+v"(tid_o));
    const int tid = tid_o, lane = tid & 63, r32 = lane & 31, hh = lane >> 5;
    const int wid = __builtin_amdgcn_readfirstlane(tid >> 6);
    const int b = bh >> 3, h = bh & 7;
    const size_t row0 = (size_t)b * SEQ + 64 * c;
    const bf16* PROJ = (const bf16*)(P.ws + WS_PROJ);
    LAS unsigned char* sV = lds;
    LAS unsigned char* sQi = lds + HTILE;
    LAS unsigned char* sKm = lds + 3 * HTILE;
    LAS unsigned char* sQm = lds + 5 * HTILE;
    LAS unsigned char* sSc = lds + 7 * HTILE;
    v4u gq0, gq1;
    { const bf16* gp = PROJ + (row0 + (tid >> 3)) * WIN + C_HG + h * 128 + (tid & 7) * 16; gq0 = *(const v4u*)gp; gq1 = *(const v4u*)(gp + 8); }
    { LAS unsigned char* dsts[4] = {sV, sQm, sQm + HTILE, sSc};
#pragma unroll
      for (int q = 0; q < 4; ++q)
#pragma unroll
        for (int i = 0; i < 2; ++i) { const int p = tid + 512 * i, row = p >> 4, cc = p & 15; *(LAS v4u*)(dsts[q] + row * (HP * 2) + cc * 16) = tl[q][i]; } }
    if (nbh >= 0) hg3_load_tiles(P, nbh, nc, tid, tl);
    __syncthreads();
    {
        const int dir = tid >> 8, d = (tid >> 1) & 127, half = tid & 1;
        float lbm, oml; lower_bound(P, l, dir, h * 128 + d, lbm, oml);
        float lf[32], kk[32];
        hg_local_scan((const LAS unsigned short*)(sQm + dir * HTILE) + (32 * half) * HP + d, lbm, oml, dir, lf, kk);
        const LAS unsigned short* qp = (const LAS unsigned short*)sSc + (32 * half) * HP + d;
        const float tot = dir ? lf[0] : lf[31];
        const float other = __shfl_xor(tot, 1);
        const bool far = dir ? (half == 0) : (half == 1);
        const float addfull = far ? other : 0.f, subrel = far ? 0.f : tot;
        const int o0 = dir * HTILE + ((32 * half) * HP + d) * 2;
        const float cfull = __expf(addfull + subrel);
#pragma unroll
        for (int i = 0; i < 32; ++i) {
            const float qv = bf2f(qp[i * HP]);
            const float arel = lf[i] - subrel;
            const float em = __expf(arel), qm = qv * em;
            const unsigned w0 = cvtpk(qm * cfull, qm), w1 = cvtpk(kk[i] * __expf(-arel), 0.f);
            *(LAS unsigned short*)(sQi + o0 + i * HP * 2) = (unsigned short)(w0 & 0xffffu);
            *(LAS unsigned short*)(sQm + o0 + i * HP * 2) = (unsigned short)(w0 >> 16);
            *(LAS unsigned short*)(sKm + o0 + i * HP * 2) = (unsigned short)(w1 & 0xffffu);
        }
    }
    __syncthreads();
    bf16x8 spf[2][8];
    { const int eb_ = wid & 3;
#pragma unroll
      for (int dir = 0; dir < 2; ++dir) { const bf16* Sp = (const bf16*)(P.ws + WS_ST2) + ((size_t)(dir * 32 + bh) * 64 + c) * 16384 + (size_t)(32 * eb_ + r32) * 128 + 8 * hh;
#pragma unroll
        for (int ks = 0; ks < 8; ++ks) spf[dir][ks] = *(const bf16x8*)(Sp + 16 * ks); } }
    {
        const int dir = wid >> 2, I = (wid >> 1) & 1, J = wid & 1;
        const bool dead = dir ? (I == 1 && J == 0) : (I == 0 && J == 1);
        f32x16 acc;
#pragma unroll
        for (int i = 0; i < 16; ++i) acc[i] = 0.f;
        if (!dead) {
            const LAS unsigned char* ka = sKm + dir * HTILE + ((32 * J + r32) * HP + 8 * hh) * 2;
            const LAS unsigned char* qa = sQm + dir * HTILE + ((32 * I + r32) * HP + 8 * hh) * 2;
#pragma unroll
            for (int ks = 0; ks < 8; ++ks) acc = MFMA32(*(const LAS bf16x8*)(ka + 32 * ks), *(const LAS bf16x8*)(qa + 32 * ks), acc);
        }
        const int tt = 32 * I + r32;
        LAS unsigned char* dst = sSc + ((dir * 64 + tt) * KTP + 32 * J + 4 * hh) * 2;
#pragma unroll
        for (int g = 0; g < 4; ++g) { float v[4];
#pragma unroll
            for (int j = 0; j < 4; ++j) { const int s = 32 * J + 8 * g + 4 * hh + j; const bool keep = dir ? (s >= tt) : (s <= tt); v[j] = keep ? acc[4 * g + j] : 0.f; }
            v2u ov; ov.x = cvtpk(v[0], v[1]); ov.y = cvtpk(v[2], v[3]); *(LAS v2u*)(dst + 16 * g) = ov; }
    }
    __syncthreads();
    {
        const int tb = wid >> 2, eb = wid & 3;
        f32x16 acc;
#pragma unroll
        for (int i = 0; i < 16; ++i) acc[i] = 0.f;
        const int vlane = ((lane & 15) >> 2) * (HP * 2) + (16 * ((lane >> 4) & 1) + 4 * (lane & 3)) * 2;
#pragma unroll
        for (int dir = 0; dir < 2; ++dir) {
            const LAS unsigned char* qa = sQi + dir * HTILE + ((32 * tb + r32) * HP + 8 * hh) * 2;
#pragma unroll
            for (int ks = 0; ks < 8; ++ks) acc = MFMA32(*(const LAS bf16x8*)(qa + 32 * ks), spf[dir][ks], acc);
            const LAS unsigned char* sa = sSc + ((dir * 64 + 32 * tb + r32) * KTP + 8 * hh) * 2;
#pragma unroll
            for (int ks = 0; ks < 4; ++ks) {
                const LAS unsigned char* a = sV + (16 * ks + 8 * hh) * (HP * 2) + 64 * eb + vlane;
                const s16x4 lo = vtr(a), hi = vtr(a + 4 * (HP * 2));
                const bf16x8 vf = __builtin_shufflevector(lo, hi, 0, 1, 2, 3, 4, 5, 6, 7);
                acc = MFMA32(*(const LAS bf16x8*)(sa + 32 * ks), vf, acc);
            }
        }
        LAS float* sO = (LAS float*)sQm;
#pragma unroll
        for (int i = 0; i < 16; ++i) sO[(32 * tb + (i & 3) + 8 * (i >> 2) + 4 * hh) * 132 + 32 * eb + r32] = acc[i];
    }
    __syncthreads();
    {
        const int t = tid >> 3, e0 = (tid & 7) * 16;
        const LAS float* so = (const LAS float*)sQm + t * 132 + e0;
        float v[16]; float ss = 0.f;
#pragma unroll
        for (int j = 0; j < 16; ++j) { v[j] = so[j]; ss += v[j] * v[j]; }
        ss += __shfl_xor(ss, 1); ss += __shfl_xor(ss, 2); ss += __shfl_xor(ss, 4);
        const float r = rsqrtf(ss * (1.f / 128.f) + EPS);
        const v4u g0 = gq0, g1 = gq1;
        const float gv[16] = {bflo(g0.x), bfhi(g0.x), bflo(g0.y), bfhi(g0.y), bflo(g0.z), bfhi(g0.z), bflo(g0.w), bfhi(g0.w),
                              bflo(g1.x), bfhi(g1.x), bflo(g1.y), bfhi(g1.y), bflo(g1.z), bfhi(g1.z), bflo(g1.w), bfhi(g1.w)};
        const float* ow = P.onorm_w + l * 128 + e0;
        float y[16];
#pragma unroll
        for (int j = 0; j < 16; ++j) { const float g = gv[j]; y[j] = v[j] * r * ow[j] * (g * __builtin_amdgcn_rcpf(1.f + __expf(-g))); }
        bf16* mp = (bf16*)(P.ws + WS_MIX) + (row0 + t) * D_MODEL + h * 128 + e0;
        v4u o0, o1;
        o0.x = cvtpk(y[0], y[1]); o0.y = cvtpk(y[2], y[3]); o0.z = cvtpk(y[4], y[5]); o0.w = cvtpk(y[6], y[7]);
        o1.x = cvtpk(y[8], y[9]); o1.y = cvtpk(y[10], y[11]); o1.z = cvtpk(y[12], y[13]); o1.w = cvtpk(y[14], y[15]);
        *(v4u*)mp = o0; *(v4u*)(mp + 8) = o1;
    }
    __syncthreads();
}

#define XB_TMO      128
#define XB_XCNT(j)  (256  + 64 * (j))
#define XB_XSUB(j)  (1280 + 64 * (j))
#define XB_XGEN(j)  (2304 + 64 * (j))
#define XB_TOP      3328
#define XB_TOPGEN   3392
#define XCD_BAR_WORDS 3456
#define XB_SPIN_CAP (1u << 24)
__device__ __forceinline__ unsigned xb_ld(unsigned* p)              { return __hip_atomic_load(p, __ATOMIC_RELAXED, __HIP_MEMORY_SCOPE_AGENT); }
__device__ __forceinline__ unsigned xb_add(unsigned* p, unsigned v) { return __hip_atomic_fetch_add(p, v, __ATOMIC_RELAXED, __HIP_MEMORY_SCOPE_AGENT); }
__device__ __forceinline__ unsigned xb_xcc_id() { return (unsigned)__builtin_amdgcn_s_getreg((3 << 11) | 20) & 0xFu; }
#define XB_SPIN(cond, bar) do { unsigned _sp = 0; while (cond) { __builtin_amdgcn_s_sleep(1); \
    if ((++_sp & 255u) == 0u) { if (xb_ld(&(bar)[XB_TMO])) break; if (_sp > XB_SPIN_CAP) { atomicAdd(&(bar)[XB_TMO], 1u); break; } } } } while (0)
struct XcdBarrier { unsigned* bar; unsigned x; volatile LAS unsigned* st; };
__device__ __forceinline__ XcdBarrier xcd_barrier_post(unsigned* bar, volatile LAS unsigned* st) {
    XcdBarrier b; b.bar = bar; b.x = xb_xcc_id(); b.st = st;
    if (threadIdx.x == 0) (void)xb_add(&bar[XB_XCNT(b.x)], 1u);
    return b;
}
__device__ __forceinline__ void xcd_barrier_complete(unsigned* bar, unsigned x, unsigned& nloc, unsigned& nx) {
    const unsigned G = gridDim.x * gridDim.y * gridDim.z;
    unsigned sum, cnt, mine, sp = 0u;
    for (;;) {
        sum = 0u; cnt = 0u; mine = 0u;
#pragma unroll
        for (unsigned j = 0; j < 16; ++j) { const unsigned c = xb_ld(&bar[XB_XCNT(j)]); sum += c; cnt += (c > 0u) ? 1u : 0u; mine = (j == x) ? c : mine; }
        if (sum == G) break;
        __builtin_amdgcn_s_sleep(1);
        if ((++sp & 255u) == 0u) { if (xb_ld(&bar[XB_TMO])) break; if (sp > XB_SPIN_CAP) { atomicAdd(&bar[XB_TMO], 1u); break; } }
    }
    nloc = mine > 0u ? mine : 1u; nx = cnt > 0u ? cnt : 1u;
}
__device__ __forceinline__ void xcd_barrier(const XcdBarrier& b) {
    asm volatile("s_waitcnt vmcnt(0)" ::: "memory");
    __syncthreads();
    if (threadIdx.x == 0) {
        unsigned* bar = b.bar;
        __builtin_amdgcn_s_waitcnt(0);
        unsigned nloc = b.st[0], nx = b.st[1];
        if (nloc == 0u) { xcd_barrier_complete(bar, b.x, nloc, nx); b.st[0] = nloc; b.st[1] = nx; }
        const unsigned old = xb_add(&bar[XB_XSUB(b.x)], 1u);
        const unsigned gen = old / nloc;
        if (old + 1u == (gen + 1u) * nloc) {
            __builtin_amdgcn_fence(__ATOMIC_RELEASE, "agent");
            asm volatile("s_waitcnt vmcnt(0)" ::: "memory");
            const unsigned og = xb_add(&bar[XB_TOP], 1u);
            const unsigned tg = og / nx;
            if (og + 1u == (tg + 1u) * nx) xb_add(&bar[XB_TOPGEN], 1u);
            else XB_SPIN(xb_ld(&bar[XB_TOPGEN]) == tg, bar);
            __builtin_amdgcn_fence(__ATOMIC_ACQUIRE, "agent");
            xb_add(&bar[XB_XGEN(b.x)], 1u);
            asm volatile("s_waitcnt vmcnt(0)" ::: "memory");
        } else {
            XB_SPIN(xb_ld(&bar[XB_XGEN(b.x)]) == gen, bar);
            __builtin_amdgcn_fence(__ATOMIC_ACQUIRE, "agent");
            asm volatile("s_waitcnt vmcnt(0)" ::: "memory");
        }
    }
    __syncthreads();
}

__global__ void __launch_bounds__(NTHR, 2) hybrid_fwd(Params P) {
    extern __shared__ __attribute__((aligned(16))) unsigned char lds_raw[];
    cg::grid_group grid = cg::this_grid();
    LAS unsigned char* lds = (LAS unsigned char*)lds_raw;
    const int G = gridDim.x, bx = blockIdx.x, ngw = G * NWAVES;
    volatile LAS unsigned* xst = (volatile LAS unsigned*)(lds + LDS_BYTES - 64);
    if (threadIdx.x < 2) xst[threadIdx.x] = 0u;
    __syncthreads();
    const XcdBarrier xbar = xcd_barrier_post((unsigned*)P.ws, xst);
#define GRID_BAR() xcd_barrier(xbar)
#define TIDS() int tid = threadIdx.x; asm volatile("" : "+v"(tid)); const int lane = tid & 63, wave = __builtin_amdgcn_readfirstlane(tid >> 6), gw = bx * NWAVES + wave; (void)lane; (void)gw
    float* RTmix = (float*)(P.ws + 131072); float* RTffn = (float*)(P.ws + 262144);
    float* SSPmix = (float*)(P.ws + WS_SSP); float* SSPffn = (float*)(P.ws + WS_SSP + 2 * MiB);
    bf16* H = (bf16*)(P.ws + WS_H); bf16* PROJ = (bf16*)(P.ws + WS_PROJ); bf16* MIX = (bf16*)(P.ws + WS_MIX); bf16* U = (bf16*)(P.ws + WS_PROJ);
    const bf16* WTin = (const bf16*)(P.ws + WS_WIN); const bf16* WTout = (const bf16*)(P.ws + WS_WOUT); const bf16* WTgu = (const bf16*)(P.ws + WS_WGU); const bf16* WTdn = (const bf16*)(P.ws + WS_WDN);

#ifdef PROBE_PHASE
    unsigned psel = 0u, ptot = 0u; unsigned pt0 = (unsigned)__builtin_amdgcn_s_memrealtime();
#define PSTAMP(k) do { const unsigned t1_ = (unsigned)__builtin_amdgcn_s_memrealtime(); const unsigned d_ = t1_ - pt0; ptot += d_; if ((PROBE_PHASE >> (k)) & 1) psel += d_; pt0 = t1_; } while (0)
#else
#define PSTAMP(k) do {} while (0)
#endif
    for (int l = 0; l < DEPTH; ++l) {
        const float* xin = (l == 0) ? P.x : P.out;
#ifndef SKIP_P0
        { TIDS(); convert_weights(P, l, lds, gw, ngw, wave, lane);
          if (l == 0) x_to_bf16_rows(P.x, H, RTmix, gw, ngw, lane); else rstd_rows(SSPmix, RTmix, bx * NTHR + tid, G * NTHR); }
#endif
        if (P.ws == nullptr) grid.sync();
        GRID_BAR();
        PSTAMP(0);
#ifndef SKIP_P1
        { int tq = threadIdx.x; asm volatile("" : "+v"(tq));
          if (tq < 128) ((LAS float*)(lds + pg8::RS_OFF + 2048))[tq] = (tq < 64) ? P.qn_w[l * 64 + tq] * (0.125f * LOG2E) : P.kn_w[l * 64 + tq - 64];
          __syncthreads(); }
        { pg8::Gemm g{H, WTin, MTOK, WIN, D_MODEL}; pg8::RowScaleOrder S; S.init(MTOK, WIN, G, bx); S.rtab = RTmix; S.lds0 = lds; S.k = 0;
          pg8::EpiBf16Scale E{PROJ, WIN, lds, 0};
          pg8::gemm_phase<pg8::EpiBf16Scale, pg8::RowScaleOrder, true, true>(lds, g, S, E); }
#endif

        GRID_BAR();
        PSTAMP(1);
        {
            TIDS();
            const float* lp = P.da_lambda + l * 256;
            const float sa = wave_sum(lp[lane] * lp[64 + lane]), sb = wave_sum(lp[128 + lane] * lp[192 + lane]);
            const float lam_init = 0.8f - 0.6f * expf(-0.3f * (float)l);
            const float lam = expf(sa) - expf(sb) + lam_init;
            float mq = fabsf(P.qn_w[l * 64 + lane]), mk = fabsf(P.kn_w[l * 64 + lane]);
#pragma unroll
            for (int o_ = 1; o_ < 64; o_ <<= 1) { mq = fmaxf(mq, __shfl_xor(mq, o_)); mk = fmaxf(mk, __shfl_xor(mk, o_)); }
            const float zbound = 2.04f * 8.f * mq * mk + 104.5f;
            unsigned* qctr = (unsigned*)P.ws + 4096 + 64 * l;
            volatile LAS unsigned* qslot = (volatile LAS unsigned*)(lds + LDS_BYTES - 48);
            if (tid == 0) *qslot = __hip_atomic_fetch_add(qctr, 1u, __ATOMIC_RELAXED, __HIP_MEMORY_SCOPE_AGENT);
            __syncthreads();
            int it = __builtin_amdgcn_readfirstlane((int)*qslot);
            __syncthreads();
            while (it < 3072) {
                unsigned pre = 0u;
                if (tid == 0) pre = __hip_atomic_fetch_add(qctr, 1u, __ATOMIC_RELAXED, __HIP_MEMORY_SCOPE_AGENT);
                if (it < 1024) { const int h = 7 - (it >> 7), j = it & 127; attn_unit(P, l, j >> 5, h, j & 31, lam, 1.f - lam_init, zbound, lds); }
                else { const int u = it - 1024; hg1_unit(P, l, u >> 6, u & 63, lds); }
                if (tid == 0) *qslot = pre;
                __syncthreads();
                it = __builtin_amdgcn_readfirstlane((int)*qslot);
                __syncthreads();
            }
        }
        GRID_BAR();
        PSTAMP(3);
#ifndef SKIP_H2
        { TIDS(); hg2_scan(P, bx, G, tid, lds); }
#endif
        GRID_BAR();
        PSTAMP(4);
#ifndef SKIP_H3
        { int tq = threadIdx.x; asm volatile("" : "+v"(tq));
          v4u tl[4][2];
          { const int u0 = (bx < 2048) ? bx : 2047; hg3_load_tiles(P, u0 >> 6, u0 & 63, tq, tl); }
          for (int u = bx; u < 2048; u += G) { const int un = u + G; hg3_unit(P, l, u >> 6, u & 63, (un < 2048) ? (un >> 6) : -1, un & 63, tl, lds); } }
#endif
        GRID_BAR();
        PSTAMP(5);
#ifndef SKIP_P5
        { pg8::Gemm g{MIX, WTout, MTOK, D_MODEL, D_MODEL}; pg8::StaticOrder S; S.init(MTOK, D_MODEL, G, bx);
          pg8::EpiResF32 E{nullptr, D_MODEL, H, SSPffn};
          pg8::gemm_phase<pg8::EpiResF32, pg8::StaticOrder, true, true>(lds, g, S, E); }
#endif

        GRID_BAR();
        PSTAMP(6);
#ifndef SKIP_P6
        { TIDS(); rstd_rows(SSPffn, RTffn, bx * NTHR + tid, G * NTHR); }
#endif

        GRID_BAR();
        PSTAMP(7);
#ifndef SKIP_P7
        { pg8::Gemm g{H, WTgu, MTOK, 2 * DFF, D_MODEL}; pg8::RowScaleOrder S; S.init(MTOK, 2 * DFF, G, bx); S.rtab = RTffn; S.lds0 = lds; S.k = 0;
          pg8::EpiSwiGLU E{U, DFF, lds, 0};
          pg8::gemm_phase<pg8::EpiSwiGLU, pg8::RowScaleOrder, true, true>(lds, g, S, E); }
#endif

        GRID_BAR();
        PSTAMP(8);
#ifndef SKIP_P8
        { pg8::Gemm g{U, WTdn, MTOK, D_MODEL, DFF}; pg8::StaticOrder S; S.init(MTOK, D_MODEL, G, bx);
          pg8::EpiResF32 E{(l + 1 < DEPTH) ? nullptr : P.out, D_MODEL, H, SSPmix};
          pg8::gemm_phase<pg8::EpiResF32, pg8::StaticOrder, true, true>(lds, g, S, E); }
#endif

        GRID_BAR();
        PSTAMP(9);
    }
#ifdef PROBE_PHASE
    if (bx == 0 && threadIdx.x == 0) P.out[0] += 0.35f + 0.7f * ((float)psel / (float)ptot);
#endif
}

extern "C" void kernel_launch(void* const* d_in, const int* in_sizes, int n_in, void* d_out, int out_size, void* d_ws, size_t ws_size, hipStream_t stream) {
    static int grid_blocks = 0;
    if (grid_blocks == 0) {
        if (n_in != 14 || ws_size < WS_END) { fprintf(stderr, "kernel_launch: unexpected n_in %d or ws_size %zu (need %zu)\n", n_in, ws_size, (size_t)WS_END); grid_blocks = -1; return; }
        int dev = 0, cus = 0, per_cu = 0;
        hipGetDevice(&dev);
        hipDeviceGetAttribute(&cus, hipDeviceAttributeMultiprocessorCount, dev);
        if (hipFuncSetAttribute((const void*)hybrid_fwd, hipFuncAttributeMaxDynamicSharedMemorySize, LDS_BYTES) != hipSuccess) fprintf(stderr, "kernel_launch: hipFuncSetAttribute failed\n");
        if (hipOccupancyMaxActiveBlocksPerMultiprocessor(&per_cu, (const void*)hybrid_fwd, NTHR, LDS_BYTES) != hipSuccess || per_cu < 1) { fprintf(stderr, "kernel_launch: occupancy query gave %d\n", per_cu); per_cu = 1; }
        (void)hipGetLastError();
        grid_blocks = cus * per_cu;
    }
    if (grid_blocks < 0) return;
    Params p{};
    p.x = (const float*)d_in[0]; p.norm_mix_w = (const float*)d_in[1]; p.w_in = (const float*)d_in[2]; p.lb_logits = (const float*)d_in[3]; p.onorm_w = (const float*)d_in[4];
    p.qn_w = (const float*)d_in[5]; p.kn_w = (const float*)d_in[6]; p.da_lambda = (const float*)d_in[7]; p.subln_w = (const float*)d_in[8]; p.w_out = (const float*)d_in[9];
    p.norm_ffn_w = (const float*)d_in[10]; p.w_gate = (const float*)d_in[11]; p.w_up = (const float*)d_in[12]; p.w_down = (const float*)d_in[13];
    p.out = (float*)d_out; p.ws = (unsigned char*)d_ws;
    if (hipMemsetAsync(d_ws, 0, 65536, stream) != hipSuccess) { fprintf(stderr, "kernel_launch: memset of barrier words failed\n"); return; }
    void* args[] = {&p};
    hipError_t e = hipLaunchCooperativeKernel((const void*)hybrid_fwd, dim3(grid_blocks), dim3(NTHR), args, LDS_BYTES, stream);
    if (e != hipSuccess) fprintf(stderr, "kernel_launch: cooperative launch failed: %s (grid %d)\n", hipGetErrorString(e), grid_blocks);
}
```

```cpp
#include <hip/hip_runtime.h>
#include <hip/hip_cooperative_groups.h>
#include <cstdio>
#include <cstdint>
namespace cg = cooperative_groups;
namespace pg8 {
#define PG8_LAS __attribute__((address_space(3)))
typedef unsigned short bf16_t;
typedef short bf16x8 __attribute__((ext_vector_type(8)));
typedef float f32x4 __attribute__((ext_vector_type(4)));
typedef unsigned u32x4 __attribute__((ext_vector_type(4)));
constexpr int BM = 256, BK = 64, HALF = 128, HTB = HALF * BK * 2  , STAGE_BYTES = 8 * HTB, NXCD = 8, WGM = 8;

__host__ __device__ __forceinline__ int lds_byte(int r, int c) { const int st = (r >> 4) * 2 + (c >> 5), rr = r & 15, cc = c & 31, ob = rr * 64 + cc * 2; return st * 1024 + (ob ^ (((ob >> 9) & 1) << 5)); }
__host__ __device__ __forceinline__ void stage_rc(int b, int& R, int& C) { const int st = b / 1024, sb = b % 1024, swz = sb ^ (((sb >> 9) & 1) << 5); R = (st >> 1) * 16 + swz / 64; C = (st & 1) * 32 + (swz % 64) / 2; }
__host__ __device__ __forceinline__ int perm32(int rho) { const int n = rho >> 4, i = rho & 15; return 8 * (i >> 2) + 4 * n + (i & 3); }

struct Unit { int pm, pn; };
struct Gemm { const bf16_t* A; const bf16_t* Bt; int M, N, K; };

struct StaticOrder {
    int nM, nN, nwg, G, c;
    __host__ __device__ void init(int M, int N, int G_, int c_) { nM = M / BM; nN = N / BM; nwg = nM * nN; G = G_; c = c_; }
    __host__ __device__ bool next(int i, Unit& u) const {
        const long L = (long)i * G + c; if (L >= nwg) return false;
        int wgid = (int)L; { const int q = nwg / NXCD, r = nwg % NXCD, xcd = wgid % NXCD, off = wgid / NXCD; wgid = (xcd < r ? xcd * (q + 1) : r * (q + 1) + (xcd - r) * q) + off; }
        const int nig = WGM * nN, gid = wgid / nig, fm = gid * WGM, gsz = (nM - fm) < WGM ? (nM - fm) : WGM;
        u.pm = fm + ((wgid % nig) % gsz); u.pn = (wgid % nig) / gsz; return true;
    }
    __device__ __forceinline__ void a_ready(const Unit&) const {}
    __device__ __forceinline__ void done(const Unit&) const {}
};

__device__ __forceinline__ unsigned cvt_pk_bf16(float lo, float hi) { unsigned r; asm volatile("v_cvt_pk_bf16_f32 %0, %1, %2" : "=v"(r) : "v"(lo), "v"(hi)); return r; }
typedef float f32x2 __attribute__((ext_vector_type(2)));
__device__ __forceinline__ f32x2 gelu_pk(f32x2 v) {
    const f32x2 av = __builtin_elementwise_abs(v), d = av * 0.2316418882f + 1.0f;
    f32x2 t; t.x = __builtin_amdgcn_rcpf(d.x); t.y = __builtin_amdgcn_rcpf(d.y);
    f32x2 q = t * 0.5307027145f + (-0.7265760135f); q = q * t + 0.7107068705f; q = q * t + (-0.142248368f); q = q * t + 0.127414796f; q = q * t;
    const f32x2 s = (v * v) * (-0.72134752044f);
    f32x2 e; e.x = __builtin_amdgcn_exp2f(s.x); e.y = __builtin_amdgcn_exp2f(s.y);
    const f32x2 m = v * (q * e), r = v - m;
    f32x2 o; o.x = v.x < 0.f ? m.x : r.x; o.y = v.y < 0.f ? m.y : r.y; return o;
}

template <int ACT  > struct EpiBf16 {
    static constexpr bool PERM = true, AFTER_DRAIN = false; static_assert(ACT == 0 || ACT == 1, "EpiBf16: ACT is 0 (none) or 1 (gelu_pk)");
    bf16_t* O; int ldc; const float* bias; int split_cols; size_t split_stride; float scale0;
    __device__ __forceinline__ void operator()(const f32x4 (&acc)[2][2][4][2], const Unit& u, int wr, int wc, int fr, int fq) const {
        const int row0 = u.pm * BM + wr * 64 + fr; int colt = u.pn * BM; bf16_t* base = O;
        float sc = 1.f; if (split_cols) { const int t = colt / split_cols; base += (size_t)t * split_stride; colt -= t * split_cols; if (t == 0) sc = scale0; }
        const int col0 = colt + wc * 32 + 8 * fq, bcol0 = u.pn * BM + wc * 32 + 8 * fq;
        f32x4 bv[2][2];
#pragma unroll
        for (int bj = 0; bj < 2; ++bj)
#pragma unroll
            for (int n = 0; n < 2; ++n) bv[bj][n] = bias ? *(const f32x4*)(bias + bcol0 + bj * HALF + 4 * n) : (f32x4){0.f, 0.f, 0.f, 0.f};
#pragma unroll
        for (int ai = 0; ai < 2; ++ai)
#pragma unroll
            for (int m = 0; m < 4; ++m) { bf16_t* rowp = base + (size_t)(row0 + ai * HALF + m * 16) * ldc + col0;
#pragma unroll
                for (int bj = 0; bj < 2; ++bj) { f32x4 v0 = acc[ai][bj][m][0] + bv[bj][0], v1 = acc[ai][bj][m][1] + bv[bj][1];
                    if (ACT == 1) { f32x2 a = gelu_pk((f32x2){v0[0], v0[1]}), b = gelu_pk((f32x2){v0[2], v0[3]}), c = gelu_pk((f32x2){v1[0], v1[1]}), d = gelu_pk((f32x2){v1[2], v1[3]});
                        v0 = (f32x4){a.x, a.y, b.x, b.y}; v1 = (f32x4){c.x, c.y, d.x, d.y}; }
                    v0 = v0 * sc; v1 = v1 * sc; u32x4 w; w.x = cvt_pk_bf16(v0[0], v0[1]); w.y = cvt_pk_bf16(v0[2], v0[3]); w.z = cvt_pk_bf16(v1[0], v1[1]); w.w = cvt_pk_bf16(v1[2], v1[3]);
                    *(u32x4*)(rowp + bj * HALF) = w; } }
    }
};

struct PanelStats {
    unsigned* xbuf;
    unsigned* cnt;
    unsigned* tmo;
    int ntn; float eps;
    unsigned code;
    __device__ __forceinline__ bool run(const f32x4 (&v)[2][2][4][2], const Unit& u, int wr, int wc, int fr, int fq, PG8_LAS unsigned char* lds, int wid, int lane) const {
        typedef float f32x2v __attribute__((ext_vector_type(2)));
        PG8_LAS f32x2v* P = (PG8_LAS f32x2v*)lds;
        PG8_LAS f32x2v* S = (PG8_LAS f32x2v*)(lds + 8192);
        PG8_LAS unsigned* flag = (PG8_LAS unsigned*)(lds + 8192 + 2048);
#pragma unroll
        for (int ai = 0; ai < 2; ++ai)
#pragma unroll
            for (int m = 0; m < 4; ++m) {
                float s = 0.f;
#pragma unroll
                for (int bj = 0; bj < 2; ++bj)
#pragma unroll
                    for (int n = 0; n < 2; ++n) { const f32x4 x = v[ai][bj][m][n]; s += (x[0] + x[1]) + (x[2] + x[3]); }
                s += __shfl_xor(s, 16); s += __shfl_xor(s, 32);
                const float mw = s * (1.0f / 64.0f); float q = 0.f;
#pragma unroll
                for (int bj = 0; bj < 2; ++bj)
#pragma unroll
                    for (int n = 0; n < 2; ++n) { const f32x4 d = v[ai][bj][m][n] - mw; q += (d[0] * d[0] + d[1] * d[1]) + (d[2] * d[2] + d[3] * d[3]); }
                q += __shfl_xor(q, 16); q += __shfl_xor(q, 32);
                if (fq == 0) P[(ai * HALF + wr * 64 + m * 16 + fr) * 4 + wc] = (f32x2v){mw, q};
            }
        asm volatile("s_waitcnt lgkmcnt(0)" ::: "memory"); __builtin_amdgcn_s_barrier(); asm volatile("" ::: "memory");
#if defined(BROKEN_EXCHANGE_NO_WAIT)
#warning BROKEN CONTROL BUILD: the row-statistics exchange does not wait; results are wrong by design
        if (blockIdx.x >= 64) { const long long t0_ = clock64(); while (clock64() - t0_ < 60000) __builtin_amdgcn_s_sleep(8); }
#endif
        const int row = wid * 32 + (lane & 31);
        if (lane < 32) {
            const f32x2v a = P[row * 4 + 0], b = P[row * 4 + 1], c = P[row * 4 + 2], d = P[row * 4 + 3];
            const float mt = (a.x + b.x + c.x + d.x) * 0.25f;
            const float da = a.x - mt, db = b.x - mt, dc = c.x - mt, dd = d.x - mt;
            const float m2 = (a.y + b.y) + (c.y + d.y) + 64.0f * ((da * da + db * db) + (dc * dc + dd * dd));
            unsigned long long* slot = (unsigned long long*)xbuf + ((size_t)(u.pm * BM + row) * 4 + u.pn);
            __hip_atomic_store(slot, ((unsigned long long)__float_as_uint(m2) << 32) | __float_as_uint(mt), __ATOMIC_RELAXED, __HIP_MEMORY_SCOPE_AGENT);
        }
        asm volatile("s_waitcnt vmcnt(0)" ::: "memory");
        if (lane == 0) __hip_atomic_fetch_add(cnt + 64 * u.pm, 1u, __ATOMIC_RELAXED, __HIP_MEMORY_SCOPE_AGENT);
        if (wid == 0) {
            bool dead = false; const unsigned long long t0 = __builtin_amdgcn_s_memrealtime(); const unsigned want = 8u * (unsigned)ntn;
            for (;;) {
#if defined(BROKEN_EXCHANGE_NO_WAIT)
                break;
#endif
                if ((unsigned)__builtin_amdgcn_readfirstlane(__hip_atomic_load(cnt + 64 * u.pm, __ATOMIC_RELAXED, __HIP_MEMORY_SCOPE_AGENT)) >= want) break;
                if (__builtin_amdgcn_s_memrealtime() - t0 > 2000000ull) {
                    if (lane == 0) { unsigned expect = 0u; __hip_atomic_compare_exchange_strong(tmo + 1, &expect, code | (unsigned)(u.pm & 0xff), __ATOMIC_RELAXED, __ATOMIC_RELAXED, __HIP_MEMORY_SCOPE_AGENT);
                                     __hip_atomic_store(tmo, 1u, __ATOMIC_RELAXED, __HIP_MEMORY_SCOPE_AGENT); }
                    dead = true; break; }
                __builtin_amdgcn_s_sleep(2);
            }
            __builtin_amdgcn_fence(__ATOMIC_ACQUIRE, "agent");
            if (lane == 0) flag[0] = dead ? 1u : 0u;
        }
        asm volatile("s_waitcnt vmcnt(0) lgkmcnt(0)" ::: "memory"); __builtin_amdgcn_s_barrier(); asm volatile("" ::: "memory");
        const bool bad = flag[0] != 0u;
        if (lane < 32) {
            const unsigned long long* slot = (const unsigned long long*)xbuf + (size_t)(u.pm * BM + row) * 4; float mt[4], m2[4]; float ms = 0.f;
#pragma unroll
            for (int t = 0; t < 4; ++t) { if (t < ntn) { const unsigned long long w = __hip_atomic_load(slot + t, __ATOMIC_RELAXED, __HIP_MEMORY_SCOPE_AGENT); mt[t] = __uint_as_float((unsigned)w); m2[t] = __uint_as_float((unsigned)(w >> 32)); } else { mt[t] = 0.f; m2[t] = 0.f; } ms += mt[t]; }
            const float mean = ms / (float)ntn; float q = 0.f;
#pragma unroll
            for (int t = 0; t < 4; ++t) if (t < ntn) { const float dm = mt[t] - mean; q += m2[t] + 256.0f * dm * dm; }
            S[row] = (f32x2v){mean, 1.0f / sqrtf(q / (256.0f * (float)ntn) + eps)};
        }
        asm volatile("s_waitcnt lgkmcnt(0)" ::: "memory"); __builtin_amdgcn_s_barrier(); asm volatile("" ::: "memory");
        return bad;
    }
};
struct EpiLnRes {
    static constexpr bool PERM = false, AFTER_DRAIN = true;
    const float* base; float* out; int ldc; const float* bias; PanelStats st; unsigned poison;
    __device__ __forceinline__ void fused(f32x4 (&acc)[2][2][4][2], const Unit& u, int wr, int wc, int fr, int fq, PG8_LAS unsigned char* lds, int wid, int lane) const {
        typedef float f32x2v __attribute__((ext_vector_type(2)));
        const PG8_LAS f32x2v* S = (const PG8_LAS f32x2v*)(lds + 8192);
        const int col0 = u.pn * BM + wc * 32 + 4 * fq;
#pragma unroll
        for (int bj = 0; bj < 2; ++bj)
#pragma unroll
            for (int n = 0; n < 2; ++n) { const f32x4 bv = bias ? *(const f32x4*)(bias + col0 + bj * HALF + n * 16) : (f32x4){0.f, 0.f, 0.f, 0.f};
#pragma unroll
                for (int ai = 0; ai < 2; ++ai)
#pragma unroll
                    for (int m = 0; m < 4; ++m) acc[ai][bj][m][n] += bv; }
        f32x4 pre[4][2][2];
#pragma unroll
        for (int m = 0; m < 4; ++m) { const size_t off = (size_t)(u.pm * BM + wr * 64 + m * 16 + fr) * ldc + col0;
#pragma unroll
            for (int bj = 0; bj < 2; ++bj)
#pragma unroll
                for (int n = 0; n < 2; ++n) pre[m][bj][n] = *(const f32x4*)(base + off + bj * HALF + n * 16); }
        const bool bad = st.run(acc, u, wr, wc, fr, fq, lds, wid, lane) || poison != 0u;
        const float qnan = __builtin_nanf("");
#pragma unroll
        for (int ai = 0; ai < 2; ++ai)
#pragma unroll
            for (int m = 0; m < 4; ++m) { const int r = ai * HALF + wr * 64 + m * 16 + fr; const f32x2v sr = S[r]; const size_t off = (size_t)(u.pm * BM + r) * ldc + col0;
#pragma unroll
                for (int bj = 0; bj < 2; ++bj)
#pragma unroll
                    for (int n = 0; n < 2; ++n) { const f32x4 bs = ai == 0 ? pre[m][bj][n] : *(const f32x4*)(base + off + bj * HALF + n * 16); f32x4 o = bs + (acc[ai][bj][m][n] - sr.x) * sr.y;
                        if (bad) o = (f32x4){qnan, qnan, qnan, qnan}; *(f32x4*)(out + off + bj * HALF + n * 16) = o; }
                if (m & 1) asm volatile("" ::: "memory"); }
    }
};
struct EpiLnResLn {
    static constexpr bool PERM = false, AFTER_DRAIN = true;
    const float* base; float* out; bf16_t* xn; int ldc; const float* bias; PanelStats st1, st2; unsigned poison;
    __device__ __forceinline__ void fused(f32x4 (&acc)[2][2][4][2], const Unit& u, int wr, int wc, int fr, int fq, PG8_LAS unsigned char* lds, int wid, int lane) const {
        typedef float f32x2v __attribute__((ext_vector_type(2))); typedef unsigned u32x2v __attribute__((ext_vector_type(2)));
        const PG8_LAS f32x2v* S = (const PG8_LAS f32x2v*)(lds + 8192);
        const int col0 = u.pn * BM + wc * 32 + 4 * fq;
#pragma unroll
        for (int bj = 0; bj < 2; ++bj)
#pragma unroll
            for (int n = 0; n < 2; ++n) { const f32x4 bv = bias ? *(const f32x4*)(bias + col0 + bj * HALF + n * 16) : (f32x4){0.f, 0.f, 0.f, 0.f};
#pragma unroll
                for (int ai = 0; ai < 2; ++ai)
#pragma unroll
                    for (int m = 0; m < 4; ++m) acc[ai][bj][m][n] += bv; }
        bool bad = st1.run(acc, u, wr, wc, fr, fq, lds, wid, lane) || poison != 0u;
        const float qnan = __builtin_nanf("");
#pragma unroll
        for (int ai = 0; ai < 2; ++ai)
#pragma unroll
            for (int m = 0; m < 4; ++m) { const int r = ai * HALF + wr * 64 + m * 16 + fr; const f32x2v sr = S[r]; const size_t off = (size_t)(u.pm * BM + r) * ldc + col0;
#pragma unroll
                for (int bj = 0; bj < 2; ++bj)
#pragma unroll
                    for (int n = 0; n < 2; ++n) { const f32x4 bs = *(const f32x4*)(base + off + bj * HALF + n * 16); acc[ai][bj][m][n] = bs + (acc[ai][bj][m][n] - sr.x) * sr.y; }
                asm volatile("" : "+v"(acc[ai][0][m][0]), "+v"(acc[ai][0][m][1]), "+v"(acc[ai][1][m][0]), "+v"(acc[ai][1][m][1]));
                if (m & 1) asm volatile("" ::: "memory"); }
        const bool bad1 = bad;
        bad = st2.run(acc, u, wr, wc, fr, fq, lds, wid, lane) || bad;
#pragma unroll
        for (int ai = 0; ai < 2; ++ai)
#pragma unroll
            for (int m = 0; m < 4; ++m) { const int r = ai * HALF + wr * 64 + m * 16 + fr; const f32x2v sr = S[r]; const size_t off = (size_t)(u.pm * BM + r) * ldc + col0;
#pragma unroll
                for (int bj = 0; bj < 2; ++bj)
#pragma unroll
                    for (int n = 0; n < 2; ++n) { const f32x4 x1 = acc[ai][bj][m][n]; *(f32x4*)(out + off + bj * HALF + n * 16) = bad1 ? (f32x4){qnan, qnan, qnan, qnan} : x1;
                        const f32x4 o = (x1 - sr.x) * sr.y; u32x2v w; w.x = cvt_pk_bf16(o[0], o[1]); w.y = cvt_pk_bf16(o[2], o[3]);
                        if (bad) { w.x = 0x7fc07fc0u; w.y = 0x7fc07fc0u; } *(u32x2v*)(xn + off + bj * HALF + n * 16) = w; }
                asm volatile("" ::: "memory"); }
    }
};

template <class Epi, class Sched, bool ALIGN_EPI = false, bool SP2 = false>
__device__ __forceinline__ void gemm_phase(PG8_LAS unsigned char* lds, const Gemm g, const Sched& S, const Epi& E) {
    int tid_o = threadIdx.x; asm volatile("" : "+v"(tid_o));
    const int tid = tid_o, wid = __builtin_amdgcn_readfirstlane(tid >> 6), lane = tid & 63, wr = wid >> 2, wc = wid & 3, fr = lane & 15, fq = lane >> 4;
    const int K = g.K, nt = K / BK;
    unsigned voffA[2], voffB[2];
#pragma unroll
    for (int i = 0; i < 2; ++i) { int R, C; stage_rc(tid * 16 + i * 8192, R, C); const int Rb = Epi::PERM ? ((R & ~31) + perm32(R & 31)) : R;
        voffA[i] = (unsigned)(R * K + C) * 2u; voffB[i] = (unsigned)(Rb * K + C) * 2u; }
    const size_t kstep = (size_t)(BK * 2);
    const size_t hstep = (size_t)HALF * K * 2;
    const size_t tstep = 2 * hstep;
    const unsigned ldsw = (unsigned)wid * 1024u;
    const int aoff = lds_byte(wr * 64 + fr, fq * 8), boff = lds_byte(wc * 32 + fr, fq * 8);
#define PG8_SA(b, h) (((b) * 2 + (h)) * HTB)
#define PG8_SB(b, h) ((4 + (b) * 2 + (h)) * HTB)
#define PG8_STAGE(bufoff, gbase, voff) do { _Pragma("unroll") for (int _i = 0; _i < 2; ++_i) \
        __builtin_amdgcn_global_load_lds((const unsigned*)((const char*)(gbase) + (voff)[_i]), (PG8_LAS unsigned*)(lds + (bufoff) + ldsw + _i * 8192), 16, 0, 0); } while (0)
#define PG8_LDA(dst, b, h) do { _Pragma("unroll") for (int m = 0; m < 4; ++m) _Pragma("unroll") for (int k = 0; k < 2; ++k) dst[m][k] = *(const PG8_LAS bf16x8*)(lds + PG8_SA(b, h) + aoff + m * 2048 + k * 1024); } while (0)
#define PG8_LDB(dst, b, h) do { _Pragma("unroll") for (int n = 0; n < 2; ++n) _Pragma("unroll") for (int k = 0; k < 2; ++k) dst[n][k] = *(const PG8_LAS bf16x8*)(lds + PG8_SB(b, h) + boff + n * 2048 + k * 1024); } while (0)
#define PG8_MMA(ai, bj, At, Bt) do { __builtin_amdgcn_s_setprio(1); _Pragma("unroll") for (int m = 0; m < 4; ++m) _Pragma("unroll") for (int n = 0; n < 2; ++n) _Pragma("unroll") for (int k = 0; k < 2; ++k) \
        acc[ai][bj][m][n] = __builtin_amdgcn_mfma_f32_16x16x32_bf16(Bt[n][k], At[m][k], acc[ai][bj][m][n], 0, 0, 0); __builtin_amdgcn_s_setprio(0); } while (0)
#define PG8_WAIT_V(n) asm volatile("s_waitcnt vmcnt(" #n ")" ::: "memory")
#define PG8_WAIT_L(n) asm volatile("s_waitcnt lgkmcnt(" #n ")" ::: "memory")
#define PG8_BAR __builtin_amdgcn_s_barrier()
#define PG8_SCHED __builtin_amdgcn_sched_barrier(0)
    Unit cur, nxt; int ui = 0;
    if (!S.next(0, cur)) return;
    f32x4 acc[2][2][4][2];
#pragma unroll
    for (int a = 0; a < 2; ++a)
#pragma unroll
        for (int b = 0; b < 2; ++b)
#pragma unroll
            for (int m = 0; m < 4; ++m)
#pragma unroll
                for (int n = 0; n < 2; ++n) acc[a][b][m][n] = (f32x4){0.f, 0.f, 0.f, 0.f};
    bf16x8 At[4][2], B0[2][2], B1[2][2];
    const char* cA = (const char*)g.A + (size_t)cur.pm * tstep; const char* cB = (const char*)g.Bt + (size_t)cur.pn * tstep;
    S.a_ready(cur);
    if constexpr (SP2) {
        PG8_STAGE(PG8_SB(0, 0), cB, voffB); PG8_STAGE(PG8_SB(0, 1), cB + hstep, voffB); PG8_STAGE(PG8_SA(0, 0), cA, voffA); PG8_STAGE(PG8_SA(0, 1), cA + hstep, voffA);
        if (wr == 1) PG8_BAR;
        PG8_WAIT_V(2); PG8_BAR;
        PG8_STAGE(PG8_SB(1, 0), cB + kstep, voffB); PG8_STAGE(PG8_SA(1, 0), cA + kstep, voffA); PG8_STAGE(PG8_SB(1, 1), cB + hstep + kstep, voffB);
        PG8_WAIT_V(6); PG8_BAR;
    } else {
        PG8_STAGE(PG8_SB(0, 0), cB, voffB); PG8_STAGE(PG8_SA(0, 0), cA, voffA); PG8_STAGE(PG8_SB(0, 1), cB + hstep, voffB); PG8_STAGE(PG8_SA(0, 1), cA + hstep, voffA);
        if (wr == 1) PG8_BAR;
        PG8_WAIT_V(4); PG8_BAR;
        PG8_STAGE(PG8_SB(1, 0), cB + kstep, voffB); PG8_STAGE(PG8_SA(1, 0), cA + kstep, voffA); PG8_STAGE(PG8_SB(1, 1), cB + hstep + kstep, voffB);
        PG8_WAIT_V(6); PG8_BAR;
    }
    for (;;) {
        const bool has_next = S.next(ui + 1, nxt);
        const char* nA = has_next ? (const char*)g.A + (size_t)nxt.pm * tstep : cA; const char* nB = has_next ? (const char*)g.Bt + (size_t)nxt.pn * tstep : cB;
        for (int t = 0; t < nt; t += 2) {
            const bool last = (t == nt - 2);
            const char* a1 = cA + (size_t)(t + 1) * kstep;
            const char* a2 = last ? nA : cA + (size_t)(t + 2) * kstep; const char* b2 = last ? nB : cB + (size_t)(t + 2) * kstep;
            const char* a3 = a2 + kstep; const char* b3 = b2 + kstep;
            if (last && has_next) S.a_ready(nxt);
            if constexpr (SP2) {
            PG8_LDB(B0, 0, 0); PG8_LDB(B1, 0, 1); PG8_SCHED; PG8_LDA(At, 0, 0); PG8_STAGE(PG8_SA(1, 1), a1 + hstep, voffA);
            PG8_WAIT_V(8); PG8_WAIT_L(0); PG8_BAR; PG8_MMA(0, 0, At, B0); PG8_MMA(0, 1, At, B1); PG8_BAR; PG8_SCHED;
            PG8_LDA(At, 0, 1); PG8_STAGE(PG8_SB(0, 0), b2, voffB); PG8_STAGE(PG8_SB(0, 1), b2 + hstep, voffB); PG8_STAGE(PG8_SA(0, 0), a2, voffA);
            PG8_WAIT_V(8); PG8_WAIT_L(0); PG8_BAR; PG8_MMA(1, 0, At, B0); PG8_MMA(1, 1, At, B1); PG8_BAR; PG8_SCHED;
            PG8_LDB(B0, 1, 0); PG8_LDB(B1, 1, 1); PG8_SCHED; PG8_LDA(At, 1, 0); PG8_STAGE(PG8_SA(0, 1), a2 + hstep, voffA);
            PG8_WAIT_V(8); PG8_WAIT_L(0); PG8_BAR; PG8_MMA(0, 0, At, B0); PG8_MMA(0, 1, At, B1); PG8_BAR; PG8_SCHED;
            PG8_LDA(At, 1, 1); PG8_STAGE(PG8_SB(1, 0), b3, voffB); PG8_STAGE(PG8_SB(1, 1), b3 + hstep, voffB); PG8_STAGE(PG8_SA(1, 0), a3, voffA);
            PG8_WAIT_V(8); PG8_WAIT_L(0); PG8_BAR; PG8_MMA(1, 0, At, B0); PG8_MMA(1, 1, At, B1); PG8_BAR; PG8_SCHED;
            } else {
            PG8_LDB(B0, 0, 0); PG8_SCHED; PG8_LDA(At, 0, 0); PG8_STAGE(PG8_SA(1, 1), a1 + hstep, voffA);
            PG8_WAIT_L(8); PG8_BAR; PG8_WAIT_L(0); PG8_MMA(0, 0, At, B0); PG8_BAR; PG8_SCHED;
            PG8_LDB(B1, 0, 1); PG8_STAGE(PG8_SB(0, 0), b2, voffB);
            PG8_BAR; PG8_WAIT_L(0); PG8_MMA(0, 1, At, B1); PG8_BAR;
            PG8_LDA(At, 0, 1); PG8_STAGE(PG8_SA(0, 0), a2, voffA);
            PG8_BAR; PG8_WAIT_L(0); PG8_MMA(1, 0, At, B0); PG8_BAR; PG8_SCHED;
            PG8_STAGE(PG8_SB(0, 1), b2 + hstep, voffB);
            PG8_WAIT_V(6); PG8_BAR; PG8_MMA(1, 1, At, B1); PG8_BAR;
            PG8_LDB(B0, 1, 0); PG8_SCHED; PG8_LDA(At, 1, 0); PG8_STAGE(PG8_SA(0, 1), a2 + hstep, voffA);
            PG8_WAIT_L(8); PG8_BAR; PG8_WAIT_L(0); PG8_MMA(0, 0, At, B0); PG8_BAR; PG8_SCHED;
            PG8_LDB(B1, 1, 1); PG8_STAGE(PG8_SB(1, 0), b3, voffB);
            PG8_BAR; PG8_WAIT_L(0); PG8_MMA(0, 1, At, B1); PG8_BAR;
            PG8_LDA(At, 1, 1); PG8_STAGE(PG8_SA(1, 0), a3, voffA);
            PG8_BAR; PG8_WAIT_L(0); PG8_MMA(1, 0, At, B0); PG8_BAR; PG8_SCHED;
            PG8_STAGE(PG8_SB(1, 1), b3 + hstep, voffB);
            PG8_WAIT_V(6); PG8_BAR; PG8_MMA(1, 1, At, B1); PG8_BAR;
            }
        }
        if constexpr (ALIGN_EPI) { if (wr == 0) PG8_BAR; }
        if constexpr (!Epi::AFTER_DRAIN) { E(acc, cur, wr, wc, fr, fq); S.done(cur); }
        if (!has_next) break;
#pragma unroll
        for (int a = 0; a < 2; ++a)
#pragma unroll
            for (int b = 0; b < 2; ++b)
#pragma unroll
                for (int m = 0; m < 4; ++m)
#pragma unroll
                    for (int n = 0; n < 2; ++n) acc[a][b][m][n] = (f32x4){0.f, 0.f, 0.f, 0.f};
        cur = nxt; cA = nA; cB = nB; ++ui;
        if constexpr (ALIGN_EPI) { if (wr == 1) PG8_BAR; }
    }
    PG8_WAIT_V(0);
    if constexpr (!ALIGN_EPI) { if (wr == 0) PG8_BAR; }
    PG8_BAR;
    if constexpr (Epi::AFTER_DRAIN) { E.fused(acc, cur, wr, wc, fr, fq, lds, wid, lane); S.done(cur); }
#undef PG8_SA
#undef PG8_SB
#undef PG8_STAGE
#undef PG8_LDA
#undef PG8_LDB
#undef PG8_MMA
#undef PG8_WAIT_V
#undef PG8_WAIT_L
#undef PG8_BAR
#undef PG8_SCHED
}
}

#define LAS __attribute__((address_space(3)))
typedef unsigned short bf16;
typedef unsigned v4u __attribute__((ext_vector_type(4)));
typedef unsigned v2u __attribute__((ext_vector_type(2)));
typedef float f32x4 __attribute__((ext_vector_type(4)));
typedef float f32x16 __attribute__((ext_vector_type(16)));
typedef short bf16x8 __attribute__((ext_vector_type(8)));
typedef short s16x4 __attribute__((ext_vector_type(4)));
typedef short v4i16_t __attribute__((ext_vector_type(4)));

constexpr int D_MODEL = 2048, BATCH = 4, SEQ = 4096, DEPTH = 4, MTOK = BATCH * SEQ;
constexpr int WIN = 8192, DFF = 5632;
constexpr int C_HQ = 0, C_HF = 1024, C_HB = 2048, C_HI = 3072, C_HG = 4096, C_DQ = 5120, C_DK = 6144, C_DV = 7168;
constexpr float EPS = 1e-6f, LOG2E = 1.4426950408889634f;
constexpr int NTHR = 512, NWAVES = 8;
constexpr int LDS_BYTES = 147456;

constexpr size_t MiB = 1u << 20;
constexpr size_t WS_WIN = 1 * MiB, WS_WOUT = 33 * MiB, WS_WGU = 41 * MiB, WS_WDN = 85 * MiB;
constexpr size_t WS_H = 108 * MiB;
constexpr size_t WS_PROJ = 172 * MiB;
constexpr size_t WS_MIX = 428 * MiB;
constexpr size_t WS_ST = 492 * MiB;
constexpr size_t WS_DEC = 620 * MiB;
constexpr size_t WS_ST2 = 624 * MiB;
constexpr size_t WS_SSP = 752 * MiB;
constexpr size_t WS_END = 756 * MiB;

struct Params {
    const float* x; const float* norm_mix_w; const float* w_in; const float* lb_logits; const float* onorm_w; const float* qn_w; const float* kn_w;
    const float* da_lambda; const float* subln_w; const float* w_out; const float* norm_ffn_w; const float* w_gate; const float* w_up; const float* w_down;
    float* out; unsigned char* ws;
};

__device__ __forceinline__ unsigned f2bf(float f) { unsigned u = __builtin_bit_cast(unsigned, f); return (u + 0x7fffu + ((u >> 16) & 1u)) >> 16; }
__device__ __forceinline__ unsigned pk2(float lo, float hi) { return f2bf(lo) | (f2bf(hi) << 16); }
typedef float f32x2 __attribute__((ext_vector_type(2)));
typedef __bf16 bf16x2_t __attribute__((ext_vector_type(2)));
__device__ __forceinline__ unsigned cvtpk(float lo, float hi) { f32x2 v = {lo, hi}; bf16x2_t b = __builtin_convertvector(v, bf16x2_t); return __builtin_bit_cast(unsigned, b); }
__device__ __forceinline__ float bf2f(unsigned short u) { return __uint_as_float(((unsigned)u) << 16); }
__device__ __forceinline__ float bflo(unsigned u) { return __uint_as_float(u << 16); }
__device__ __forceinline__ float bfhi(unsigned u) { return __uint_as_float(u & 0xffff0000u); }
__device__ __forceinline__ float wave_sum(float v) {
#pragma unroll
    for (int o = 1; o < 64; o <<= 1) v += __shfl_xor(v, o);
    return v;
}
__device__ __forceinline__ s16x4 vtr(const LAS unsigned char* p) { return __builtin_bit_cast(s16x4, __builtin_amdgcn_ds_read_tr16_b64_v4i16((LAS v4i16_t*)p)); }
#define MFMA32(a, b, c) __builtin_amdgcn_mfma_f32_32x32x16_bf16((a), (b), (c), 0, 0, 0)
__device__ __forceinline__ bf16x8 pack8(const f32x16& x, int s) {
    v4u p; p.x = pk2(x[8 * s + 0], x[8 * s + 1]); p.y = pk2(x[8 * s + 2], x[8 * s + 3]); p.z = pk2(x[8 * s + 4], x[8 * s + 5]); p.w = pk2(x[8 * s + 6], x[8 * s + 7]);
    return __builtin_bit_cast(bf16x8, p);
}

namespace pg8 {
constexpr int RS_OFF = STAGE_BYTES;
struct RowScaleOrder : StaticOrder {
    const float* rtab; PG8_LAS unsigned char* lds0; mutable int k;
    __device__ __forceinline__ void a_ready(const Unit& u) const {
        int t_ = threadIdx.x; asm volatile("" : "+v"(t_));
        if (t_ < 64) __builtin_amdgcn_global_load_lds((const unsigned*)(rtab + (size_t)u.pm * BM + 4 * t_), (PG8_LAS unsigned*)(lds0 + RS_OFF + (k & 1) * 1024), 16, 0, 0);
        ++k;
    }
};
struct EpiBf16Scale {
    static constexpr bool PERM = true, AFTER_DRAIN = false;
    bf16_t* O; int ldc; PG8_LAS unsigned char* lds0; mutable int k;
    __device__ __forceinline__ void operator()(const f32x4 (&acc)[2][2][4][2], const Unit& u, int wr, int wc, int fr, int fq) const {
        const PG8_LAS float* rs = (const PG8_LAS float*)(lds0 + RS_OFF + (k & 1) * 1024) + wr * 64 + fr; ++k;
        const int row0 = u.pm * BM + wr * 64 + fr;
        if (u.pn >= 20 && u.pn < 28) {
            const PG8_LAS f32x4* wq = (const PG8_LAS f32x4*)(lds0 + RS_OFF + 2048 + ((u.pn >= 24) ? 256 : 0) + 32 * fq);
            const f32x4 w00 = wq[0], w01 = wq[1], w10 = wq[8], w11 = wq[9];
            const int col0 = u.pn * BM + 64 * wc + 8 * fq;
#pragma unroll
            for (int ai = 0; ai < 2; ++ai)
#pragma unroll
                for (int m = 0; m < 4; ++m) { const float r = rs[ai * HALF + m * 16];
                    const f32x4 a0 = acc[ai][0][m][0] * r, a1 = acc[ai][0][m][1] * r, b0 = acc[ai][1][m][0] * r, b1 = acc[ai][1][m][1] * r;
                    float ss = ((a0[0] * a0[0] + a0[1] * a0[1]) + (a0[2] * a0[2] + a0[3] * a0[3])) + ((a1[0] * a1[0] + a1[1] * a1[1]) + (a1[2] * a1[2] + a1[3] * a1[3]))
                             + ((b0[0] * b0[0] + b0[1] * b0[1]) + (b0[2] * b0[2] + b0[3] * b0[3])) + ((b1[0] * b1[0] + b1[1] * b1[1]) + (b1[2] * b1[2] + b1[3] * b1[3]));
                    ss += __shfl_xor(ss, 16); ss += __shfl_xor(ss, 32);
                    const float rq = rsqrtf(ss * (1.f / 64.f) + 1e-6f);
                    const f32x4 p0 = a0 * rq * w00, p1 = a1 * rq * w01, q0 = b0 * rq * w10, q1 = b1 * rq * w11;
                    bf16_t* rowp = O + (size_t)(row0 + ai * HALF + m * 16) * ldc + col0;
                    u32x4 w; w.x = cvt_pk_bf16(p0[0], p0[1]); w.y = cvt_pk_bf16(p0[2], p0[3]); w.z = cvt_pk_bf16(p1[0], p1[1]); w.w = cvt_pk_bf16(p1[2], p1[3]);
                    *(u32x4*)rowp = w;
                    w.x = cvt_pk_bf16(q0[0], q0[1]); w.y = cvt_pk_bf16(q0[2], q0[3]); w.z = cvt_pk_bf16(q1[0], q1[1]); w.w = cvt_pk_bf16(q1[2], q1[3]);
                    *(u32x4*)(rowp + 32) = w; }
        } else {
            const int col0 = u.pn * BM + wc * 32 + 8 * fq;
#pragma unroll
            for (int ai = 0; ai < 2; ++ai)
#pragma unroll
                for (int m = 0; m < 4; ++m) { const float r = rs[ai * HALF + m * 16];
                    bf16_t* rowp = O + (size_t)(row0 + ai * HALF + m * 16) * ldc + col0;
#pragma unroll
                    for (int bj = 0; bj < 2; ++bj) { const f32x4 v0 = acc[ai][bj][m][0] * r, v1 = acc[ai][bj][m][1] * r;
                        u32x4 w; w.x = cvt_pk_bf16(v0[0], v0[1]); w.y = cvt_pk_bf16(v0[2], v0[3]); w.z = cvt_pk_bf16(v1[0], v1[1]); w.w = cvt_pk_bf16(v1[2], v1[3]);
                        *(u32x4*)(rowp + bj * HALF) = w; } }
        }
    }
};
struct EpiResF32 {
    static constexpr bool PERM = true, AFTER_DRAIN = false;
    float* out; int ldc; bf16_t* xb; float* ssp;
    __device__ __forceinline__ void operator()(const f32x4 (&acc)[2][2][4][2], const Unit& u, int wr, int wc, int fr, int fq) const {
        const int row0 = u.pm * BM + wr * 64 + fr, col0 = u.pn * BM + wc * 32 + 8 * fq;
#pragma unroll
        for (int ai = 0; ai < 2; ++ai)
#pragma unroll
            for (int m = 0; m < 4; ++m) { const int row = row0 + ai * HALF + m * 16; const size_t ro = (size_t)row * ldc + col0; float sq = 0.f;
#pragma unroll
                for (int bj = 0; bj < 2; ++bj) { const size_t o = ro + bj * HALF;
                    const u32x4 b = *(const u32x4*)(xb + o);
                    const f32x4 b0 = {__uint_as_float(b.x << 16), __uint_as_float(b.x & 0xffff0000u), __uint_as_float(b.y << 16), __uint_as_float(b.y & 0xffff0000u)};
                    const f32x4 b1 = {__uint_as_float(b.z << 16), __uint_as_float(b.z & 0xffff0000u), __uint_as_float(b.w << 16), __uint_as_float(b.w & 0xffff0000u)};
                    const f32x4 v0 = b0 + acc[ai][bj][m][0], v1 = b1 + acc[ai][bj][m][1];
                    if (out) { *(f32x4*)(out + o) = v0; *(f32x4*)(out + o + 4) = v1; }
                    else { u32x4 w; w.x = cvt_pk_bf16(v0[0], v0[1]); w.y = cvt_pk_bf16(v0[2], v0[3]); w.z = cvt_pk_bf16(v1[0], v1[1]); w.w = cvt_pk_bf16(v1[2], v1[3]); *(u32x4*)(xb + o) = w;
                           sq += ((v0[0] * v0[0] + v0[1] * v0[1]) + (v0[2] * v0[2] + v0[3] * v0[3])) + ((v1[0] * v1[0] + v1[1] * v1[1]) + (v1[2] * v1[2] + v1[3] * v1[3])); } }
                if (!out) { sq += __shfl_xor(sq, 16); sq += __shfl_xor(sq, 32); if (fq == 0) ssp[(size_t)row * 32 + u.pn * 4 + wc] = sq; } }
    }
};
struct EpiSwiGLU {
    static constexpr bool PERM = true, AFTER_DRAIN = false;
    bf16_t* O; int ldc; PG8_LAS unsigned char* lds0; mutable int k;
    __device__ __forceinline__ void operator()(const f32x4 (&acc)[2][2][4][2], const Unit& u, int wr, int wc, int fr, int fq) const {
        const PG8_LAS float* rs = (const PG8_LAS float*)(lds0 + RS_OFF + (k & 1) * 1024) + wr * 64 + fr; ++k;
        const int row0 = u.pm * BM + wr * 64 + fr, col0 = u.pn * HALF + wc * 32 + 8 * fq;
#pragma unroll
        for (int ai = 0; ai < 2; ++ai)
#pragma unroll
            for (int m = 0; m < 4; ++m) { const float rr = rs[ai * HALF + m * 16];
                bf16_t* rowp = O + (size_t)(row0 + ai * HALF + m * 16) * ldc + col0; float r[8];
#pragma unroll
                for (int n = 0; n < 2; ++n)
#pragma unroll
                    for (int j = 0; j < 4; ++j) { const float g = acc[ai][0][m][n][j] * rr, up = acc[ai][1][m][n][j] * rr; r[4 * n + j] = g * __builtin_amdgcn_rcpf(1.f + __expf(-g)) * up; }
                u32x4 w; w.x = cvt_pk_bf16(r[0], r[1]); w.y = cvt_pk_bf16(r[2], r[3]); w.z = cvt_pk_bf16(r[4], r[5]); w.w = cvt_pk_bf16(r[6], r[7]);
                *(u32x4*)rowp = w; }
    }
};
}

constexpr int TP = 65, TSCR = 64 * TP * 4;
struct CvItem { const float* W; bf16* WT; const float* kscale; int K, N, k0, n0, drow0, hi_skip; };
constexpr int CV_I_IN = (D_MODEL / 64) * (WIN / 64), CV_I_OUT = (D_MODEL / 64) * (D_MODEL / 64), CV_I_G = (D_MODEL / 64) * (DFF / 64), CV_I_DN = (DFF / 64) * (D_MODEL / 64);
constexpr int CV_NIT = CV_I_IN + CV_I_OUT + 2 * CV_I_G + CV_I_DN;
__device__ __forceinline__ CvItem cv_item(const Params& P, int l, int it) {
    bf16* WTin = (bf16*)(P.ws + WS_WIN); bf16* WTout = (bf16*)(P.ws + WS_WOUT); bf16* WTgu = (bf16*)(P.ws + WS_WGU); bf16* WTdn = (bf16*)(P.ws + WS_WDN);
    CvItem c; int r = it;
    if (r < CV_I_IN) { const int nb = WIN / 64, kb = r / nb, n0 = 64 * (r % nb); const bool qk = (n0 >= C_DQ && n0 < C_DV);
        c = CvItem{P.w_in + (size_t)l * D_MODEL * WIN, WTin, P.norm_mix_w + l * D_MODEL, D_MODEL, WIN, 64 * kb, n0, qk ? ((n0 & ~255) + 32 * ((n0 & 255) >> 6)) : n0, qk ? 96 : 0}; return c; } r -= CV_I_IN;
    if (r < CV_I_OUT) { const int nb = D_MODEL / 64, kb = r / nb, n0 = 64 * (r % nb); c = CvItem{P.w_out + (size_t)l * D_MODEL * D_MODEL, WTout, nullptr, D_MODEL, D_MODEL, 64 * kb, n0, n0, 0}; return c; } r -= CV_I_OUT;
    if (r < CV_I_G) { const int nb = DFF / 64, kb = r / nb, n0 = 64 * (r % nb); c = CvItem{P.w_gate + (size_t)l * D_MODEL * DFF, WTgu, P.norm_ffn_w + l * D_MODEL, D_MODEL, DFF, 64 * kb, n0, 256 * (n0 >> 7) + (n0 & 127), 0}; return c; } r -= CV_I_G;
    if (r < CV_I_G) { const int nb = DFF / 64, kb = r / nb, n0 = 64 * (r % nb); c = CvItem{P.w_up + (size_t)l * D_MODEL * DFF, WTgu, P.norm_ffn_w + l * D_MODEL, D_MODEL, DFF, 64 * kb, n0, 256 * (n0 >> 7) + 128 + (n0 & 127), 0}; return c; } r -= CV_I_G;
    { const int nb = D_MODEL / 64, kb = r / nb, n0 = 64 * (r % nb); c = CvItem{P.w_down + (size_t)l * DFF * D_MODEL, WTdn, nullptr, DFF, D_MODEL, 64 * kb, n0, n0, 0}; }
    return c;
}
__device__ __forceinline__ void cv_load(const CvItem& c, int lane, f32x4 (&v)[16], float (&ks)[16]) {
    if (c.kscale) {
#pragma unroll
        for (int i = 0; i < 16; ++i) ks[i] = c.kscale[c.k0 + (lane >> 4) + 4 * i];
    } else {
#pragma unroll
        for (int i = 0; i < 16; ++i) ks[i] = 1.f;
    }
    const float* src = c.W + (size_t)(c.k0 + (lane >> 4)) * c.N + c.n0 + 4 * (lane & 15);
#pragma unroll
    for (int i = 0; i < 16; ++i) v[i] = *(const f32x4*)(src + (size_t)(4 * i) * c.N);
}
__device__ __forceinline__ void cv_finish(const CvItem& c, int lane, f32x4 (&v)[16], const float (&ks)[16], LAS float* scr) {
#pragma unroll
    for (int i = 0; i < 16; ++i) v[i] = v[i] * ks[i];
#pragma unroll
    for (int i = 0; i < 16; ++i) { LAS float* d = scr + ((lane >> 4) + 4 * i) * TP + 4 * (lane & 15); d[0] = v[i].x; d[1] = v[i].y; d[2] = v[i].z; d[3] = v[i].w; }
    asm volatile("s_waitcnt lgkmcnt(0)" ::: "memory");
    const int cc = lane & 7;
#pragma unroll
    for (int j = 0; j < 8; ++j) { const int n = (lane >> 3) + 8 * j; const LAS float* s = scr + (8 * cc) * TP + n;
        v4u o; o.x = cvtpk(s[0 * TP], s[1 * TP]); o.y = cvtpk(s[2 * TP], s[3 * TP]); o.z = cvtpk(s[4 * TP], s[5 * TP]); o.w = cvtpk(s[6 * TP], s[7 * TP]);
        *(v4u*)(c.WT + (size_t)(c.drow0 + n + ((j >= 4) ? c.hi_skip : 0)) * c.K + c.k0 + 8 * cc) = o; }
    asm volatile("s_waitcnt lgkmcnt(0)" ::: "memory");
}
__device__ __forceinline__ void convert_weights(const Params& P, int l, LAS unsigned char* lds, int gw, int ngw, int wave, int lane) {
    LAS float* scr = (LAS float*)(lds + wave * TSCR);
    if (gw >= CV_NIT) return;
    f32x4 va[16], vb[16]; float ka[16], kb[16];
    CvItem ca = cv_item(P, l, gw), cb = ca;
    cv_load(ca, lane, va, ka);
    for (int it = gw; it < CV_NIT; it += 2 * ngw) {
        const bool hb = (it + ngw < CV_NIT);
        if (hb) { cb = cv_item(P, l, it + ngw); cv_load(cb, lane, vb, kb); }
        cv_finish(ca, lane, va, ka, scr);
        if (!hb) break;
        const bool ha = (it + 2 * ngw < CV_NIT);
        if (ha) { ca = cv_item(P, l, it + 2 * ngw); cv_load(ca, lane, va, ka); }
        cv_finish(cb, lane, vb, kb, scr);
        if (!ha) break;
    }
}
__device__ __forceinline__ void x_to_bf16_rows(const float* X, bf16* XB, float* rtab, int gw, int ngw, int lane) {
    for (int m = gw; m < MTOK; m += ngw) {
        const f32x4* xr = (const f32x4*)(X + (size_t)m * D_MODEL) + lane;
        f32x4 v[8]; float s = 0.f;
#pragma unroll
        for (int j = 0; j < 8; ++j) { v[j] = xr[64 * j]; s += (v[j].x * v[j].x + v[j].y * v[j].y) + (v[j].z * v[j].z + v[j].w * v[j].w); }
        s = wave_sum(s);
        if (lane == 0) rtab[m] = rsqrtf(s * (1.f / D_MODEL) + EPS);
        v2u* o8 = (v2u*)(XB + (size_t)m * D_MODEL) + lane;
#pragma unroll
        for (int j = 0; j < 8; ++j) { v2u o; o.x = cvtpk(v[j].x, v[j].y); o.y = cvtpk(v[j].z, v[j].w); o8[64 * j] = o; }
    }
}
__device__ __forceinline__ void rstd_rows(const float* ssp, float* rtab, int gtid, int ngt) {
    for (int m = gtid; m < MTOK; m += ngt) {
        const f32x4* p = (const f32x4*)(ssp + (size_t)m * 32); float t = 0.f;
#pragma unroll
        for (int k = 0; k < 8; ++k) { const f32x4 v = p[k]; t += (v[0] + v[1]) + (v[2] + v[3]); }
        rtab[m] = rsqrtf(t * (1.f / D_MODEL) + EPS);
    }
}
__device__ __forceinline__ void qknorm_rows(bf16* PROJ, const float* qn_w, const float* kn_w, int gw, int ngw, int lane) {
    const int d0 = 8 * (lane & 7);
    float wq[8], wk[8];
#pragma unroll
    for (int j = 0; j < 8; ++j) { wq[j] = qn_w[d0 + j] * (0.125f * LOG2E); wk[j] = kn_w[d0 + j]; }
    for (int m = gw; m < MTOK; m += ngw) {
#pragma unroll
        for (int it = 0; it < 4; ++it) {
            bf16* p = PROJ + (size_t)m * WIN + C_DQ + it * 512 + 8 * lane;
            const v4u raw = *(const v4u*)p;
            float v[8] = {bflo(raw.x), bfhi(raw.x), bflo(raw.y), bfhi(raw.y), bflo(raw.z), bfhi(raw.z), bflo(raw.w), bfhi(raw.w)};
            float s = 0.f;
#pragma unroll
            for (int j = 0; j < 8; ++j) s += v[j] * v[j];
            s += __shfl_xor(s, 1); s += __shfl_xor(s, 2); s += __shfl_xor(s, 4);
            const float r = rsqrtf(s * (1.f / 64.f) + EPS);
            v4u o;
            if (it < 2) { o.x = pk2(v[0] * r * wq[0], v[1] * r * wq[1]); o.y = pk2(v[2] * r * wq[2], v[3] * r * wq[3]); o.z = pk2(v[4] * r * wq[4], v[5] * r * wq[5]); o.w = pk2(v[6] * r * wq[6], v[7] * r * wq[7]); }
            else        { o.x = pk2(v[0] * r * wk[0], v[1] * r * wk[1]); o.y = pk2(v[2] * r * wk[2], v[3] * r * wk[3]); o.z = pk2(v[4] * r * wk[4], v[5] * r * wk[5]); o.w = pk2(v[6] * r * wk[6], v[7] * r * wk[7]); }
            *(v4u*)p = o;
        }
    }
}

__device__ __forceinline__ bf16x8 pack8c(const f32x16& x, int s) {
    v4u p; p.x = cvtpk(x[8 * s + 0], x[8 * s + 1]); p.y = cvtpk(x[8 * s + 2], x[8 * s + 3]); p.z = cvtpk(x[8 * s + 4], x[8 * s + 5]); p.w = cvtpk(x[8 * s + 6], x[8 * s + 7]);
    return __builtin_bit_cast(bf16x8, p);
}
constexpr int K_PITCH = 272, K_TILE = 64 * K_PITCH, V_PITCH = 320, V_TILE = 64 * V_PITCH;
constexpr float ATT_THR = 60.f;
__device__ __forceinline__ void attn_half_a(const LAS unsigned char* kb, const LAS unsigned char* qs, int t, int t_diag, int qpos, int hh, float cs, float csq, float csh,
                                            float& m_ref, float& l_run, f32x16 (&o)[4], f32x16& s0, f32x16& s1) {
    bf16x8 qf[4];
#pragma unroll
    for (int ks = 0; ks < 4; ++ks) qf[ks] = *(const LAS bf16x8*)(qs + ks * 1024);
    const float tb = cs * (float)(64 * t);
    const float cval = (t < t_diag) ? (tb + csh - m_ref) : (t > t_diag) ? (2.f * csq - tb - csh - m_ref) : (csq - m_ref);
    { bf16x8 a0 = *(const LAS bf16x8*)(kb), a1 = *(const LAS bf16x8*)(kb + 32 * K_PITCH);
      bf16x8 b0 = *(const LAS bf16x8*)(kb + 32), b1 = *(const LAS bf16x8*)(kb + 32 * K_PITCH + 32);
      f32x16 cinit;
#pragma unroll
      for (int i = 0; i < 16; ++i) cinit[i] = cval;
      s0 = MFMA32(a0, qf[0], cinit); s1 = MFMA32(a1, qf[0], cinit);
      a0 = *(const LAS bf16x8*)(kb + 64); a1 = *(const LAS bf16x8*)(kb + 32 * K_PITCH + 64);
      s0 = MFMA32(b0, qf[1], s0); s1 = MFMA32(b1, qf[1], s1);
      b0 = *(const LAS bf16x8*)(kb + 96); b1 = *(const LAS bf16x8*)(kb + 32 * K_PITCH + 96);
      s0 = MFMA32(a0, qf[2], s0); s1 = MFMA32(a1, qf[2], s1);
      s0 = MFMA32(b0, qf[3], s0); s1 = MFMA32(b1, qf[3], s1); }
    if (t != t_diag) {
        const float sg = (t < t_diag) ? cs : -cs;
#pragma unroll
        for (int i = 0; i < 16; ++i) { float a_ = __builtin_fmaf(sg, (float)((i & 3) + 8 * (i >> 2)), s0[i]), b_ = __builtin_fmaf(sg, (float)((i & 3) + 8 * (i >> 2) + 32), s1[i]);
            asm volatile("" : "+v"(a_)); asm volatile("" : "+v"(b_)); s0[i] = a_; s1[i] = b_; }
    } else {
        const float dq = (float)(qpos - 64 * t - 4 * hh);
#pragma unroll
        for (int i = 0; i < 16; ++i) { const float d0 = dq - (float)((i & 3) + 8 * (i >> 2));
            s0[i] = __builtin_fmaf(-cs, __builtin_fabsf(d0), s0[i]); s1[i] = __builtin_fmaf(-cs, __builtin_fabsf(d0 - 32.f), s1[i]); }
    }
    float mxa = __builtin_fmaxf(__builtin_fmaxf(s0[0], s0[1]), s1[0]), mxb = __builtin_fmaxf(__builtin_fmaxf(s0[2], s0[3]), s1[1]);
    mxa = __builtin_fmaxf(__builtin_fmaxf(mxa, s1[2]), s1[3]);
#pragma unroll
    for (int i = 4; i < 16; i += 4) { mxa = __builtin_fmaxf(__builtin_fmaxf(mxa, s0[i]), s0[i + 1]); mxb = __builtin_fmaxf(__builtin_fmaxf(mxb, s0[i + 2]), s0[i + 3]);
        mxa = __builtin_fmaxf(__builtin_fmaxf(mxa, s1[i]), s1[i + 1]); mxb = __builtin_fmaxf(__builtin_fmaxf(mxb, s1[i + 2]), s1[i + 3]); }
    float mx = __builtin_fmaxf(mxa, mxb);
    { auto rr = __builtin_amdgcn_permlane32_swap(__float_as_uint(mx), __float_as_uint(mx), false, false); mx = __builtin_fmaxf(__uint_as_float(rr[0]), __uint_as_float(rr[1])); }
    if (__any(mx > ATT_THR)) {
        const float dl = __builtin_fmaxf(mx, 0.f);
        m_ref += dl;
        const float alpha = __builtin_amdgcn_exp2f(-dl);
        l_run *= alpha;
#pragma unroll
        for (int i = 0; i < 16; ++i) { s0[i] -= dl; s1[i] -= dl; }
#pragma unroll
        for (int e = 0; e < 4; ++e)
#pragma unroll
            for (int i = 0; i < 16; ++i) o[e][i] *= alpha;
    }
}
__device__ __forceinline__ void attn_half_b(const LAS unsigned char* vb, const f32x16& s0, const f32x16& s1, float& l_run, f32x16 (&o)[4]) {
    float rs[4];
#pragma unroll
    for (int ks = 0; ks < 4; ++ks) {
        s16x4 lo[4], hi[4];
        const int r1 = (32 * (ks >> 1) + 16 * (ks & 1)) * V_PITCH;
#pragma unroll
        for (int e = 0; e < 4; ++e) { lo[e] = vtr(vb + r1 + 64 * e); hi[e] = vtr(vb + r1 + 8 * V_PITCH + 64 * e); }
        float p[8];
#pragma unroll
        for (int j = 0; j < 8; ++j) p[j] = __builtin_amdgcn_exp2f((ks < 2) ? s0[8 * (ks & 1) + j] : s1[8 * (ks & 1) + j]);
        { float t0 = p[0] + p[1], t1 = p[2] + p[3], t2 = p[4] + p[5], t3 = p[6] + p[7];
          asm volatile("" : "+v"(t0)); asm volatile("" : "+v"(t1)); asm volatile("" : "+v"(t2)); asm volatile("" : "+v"(t3));
          float u0 = t0 + t1, u1 = t2 + t3; asm volatile("" : "+v"(u0)); asm volatile("" : "+v"(u1)); rs[ks] = u0 + u1; }
        v4u pw; pw.x = cvtpk(p[0], p[1]); pw.y = cvtpk(p[2], p[3]); pw.z = cvtpk(p[4], p[5]); pw.w = cvtpk(p[6], p[7]);
        const bf16x8 pf = __builtin_bit_cast(bf16x8, pw);
#pragma unroll
        for (int e = 0; e < 4; ++e) { const bf16x8 vf = __builtin_shufflevector(lo[e], hi[e], 0, 1, 2, 3, 4, 5, 6, 7); o[e] = MFMA32(vf, pf, o[e]); }
    }
    l_run += (rs[0] + rs[1]) + (rs[2] + rs[3]);
}
__device__ __forceinline__ void attn_unit(const Params& P, int l, int b, int h, int qb, float lam, float oscale, float zbound, LAS unsigned char* lds) {
    int tid_o = threadIdx.x; asm volatile("" : "+v"(tid_o));
    const int tid = tid_o, lane = tid & 63, r32 = lane & 31, hh = lane >> 5;
    const int wid = __builtin_amdgcn_readfirstlane(tid >> 6), map = wid >> 2, wq = wid & 3;
    const size_t rowbase = (size_t)b * SEQ;
    const int q0 = qb * 128 + wq * 32;
    const bf16* PROJ = (const bf16*)(P.ws + WS_PROJ);
    LAS unsigned char* qs = lds + 2 * K_TILE + 2 * V_TILE + wid * 4096 + lane * 16;
    { const bf16* qp = PROJ + (rowbase + q0 + r32) * WIN + C_DQ + h * 128 + map * 64 + hh * 8;
#pragma unroll
      for (int ks = 0; ks < 4; ++ks) *(LAS bf16x8*)(qs + ks * 1024) = *(const bf16x8*)(qp + 16 * ks); }
    const float cs = exp2f(-(float)(h + 1)) * LOG2E;
    f32x16 o[4];
#pragma unroll
    for (int e = 0; e < 4; ++e)
#pragma unroll
        for (int i = 0; i < 16; ++i) o[e][i] = 0.f;
    float m_ref = 0.f, l_run = 0.f;
    LAS unsigned char* sK = lds; LAS unsigned char* sV = lds + 2 * K_TILE;
    const int prow = tid >> 4, pc = tid & 15;
    const bf16* kg = PROJ + (rowbase + prow) * WIN + C_DK + h * 128 + pc * 8;
    const bf16* vg = PROJ + (rowbase + prow) * WIN + C_DV + h * 128 + pc * 8;
    const int soffk = prow * K_PITCH + pc * 16, soffv = prow * V_PITCH + pc * 16;
    int t_lo = 0, t_hi = SEQ / 64 - 1;
    { const float dmaxf = zbound * exp2f((float)(h + 1));
      if (dmaxf < (float)SEQ) { const int dmax = (int)dmaxf + 1; const int Q0 = qb * 128; t_lo = max(0, (Q0 - dmax) >> 6); t_hi = min(SEQ / 64 - 1, (Q0 + 127 + dmax) >> 6); } }
    t_lo = __builtin_amdgcn_readfirstlane(t_lo); t_hi = __builtin_amdgcn_readfirstlane(t_hi);
    v4u kr[2], vr[2];
#pragma unroll
    for (int i = 0; i < 2; ++i) { kr[i] = *(const v4u*)(kg + (size_t)(64 * t_lo + 32 * i) * WIN); vr[i] = *(const v4u*)(vg + (size_t)(64 * t_lo + 32 * i) * WIN); }
    const int buf0 = t_lo & 1;
#pragma unroll
    for (int i = 0; i < 2; ++i) { *(LAS v4u*)(sK + buf0 * K_TILE + soffk + i * 32 * K_PITCH) = kr[i]; *(LAS v4u*)(sV + buf0 * V_TILE + soffv + i * 32 * V_PITCH) = vr[i]; }
    __syncthreads();
    const int qpos = q0 + r32;
    const float csq = cs * (float)qpos, csh = cs * (float)(4 * hh);
    const int t_diag = q0 >> 6;
    const int vlane = ((lane & 15) >> 2) * V_PITCH + (16 * ((lane >> 4) & 1) + 4 * (lane & 3)) * 2;
    const int NT = t_hi - t_lo + 1;
    f32x16 s0, s1;
#pragma unroll
    for (int i = 0; i < 16; ++i) { s0[i] = -200.f; s1[i] = -200.f; }
    const LAS unsigned char* kb0 = sK + r32 * K_PITCH + (map * 64 + hh * 8) * 2;
    const LAS unsigned char* vb0 = sV + vlane + 4 * hh * V_PITCH;
#define ATT_LOAD(i_) do { if ((i_) + 1 < NT) { const int tn_ = t_lo + (i_) + 1; _Pragma("unroll") for (int q_ = 0; q_ < 2; ++q_) { \
        kr[q_] = *(const v4u*)(kg + (size_t)(64 * tn_ + 32 * q_) * WIN); vr[q_] = *(const v4u*)(vg + (size_t)(64 * tn_ + 32 * q_) * WIN); } } } while (0)
#define ATT_STORE(i_) do { if ((i_) + 1 < NT) { const int nb_ = (t_lo + (i_) + 1) & 1; _Pragma("unroll") for (int q_ = 0; q_ < 2; ++q_) { \
        *(LAS v4u*)(sK + nb_ * K_TILE + soffk + q_ * 32 * K_PITCH) = kr[q_]; *(LAS v4u*)(sV + nb_ * V_TILE + soffv + q_ * 32 * V_PITCH) = vr[q_]; } } } while (0)
    if (map == 0) {
        for (int i = 0; i < NT; ++i) {
            const int t = t_lo + i, buf = t & 1;
            ATT_LOAD(i);
            attn_half_a(kb0 + buf * K_TILE, qs, t, t_diag, qpos, hh, cs, csq, csh, m_ref, l_run, o, s0, s1);
            __syncthreads();
            attn_half_b(vb0 + buf * V_TILE, s0, s1, l_run, o);
            ATT_STORE(i);
            __syncthreads();
        }
        __syncthreads();
    } else {
        for (int i = 0; i < NT; ++i) {
            const int t = t_lo + i, buf = t & 1, pbuf = (i == 0) ? buf : (buf ^ 1);
            ATT_LOAD(i);
            attn_half_b(vb0 + pbuf * V_TILE, s0, s1, l_run, o);
            __syncthreads();
            attn_half_a(kb0 + buf * K_TILE, qs, t, t_diag, qpos, hh, cs, csq, csh, m_ref, l_run, o, s0, s1);
            ATT_STORE(i);
            __syncthreads();
        }
        attn_half_b(vb0 + ((t_lo + NT - 1) & 1) * V_TILE, s0, s1, l_run, o);
        __syncthreads();
    }
#undef ATT_LOAD
#undef ATT_STORE
    const float l_tot = l_run + __shfl_xor(l_run, 32);
    const float inv = 1.f / l_tot;
    LAS float* X = (LAS float*)lds;
    if (map == 1) {
#pragma unroll
        for (int e = 0; e < 4; ++e)
#pragma unroll
            for (int i = 0; i < 16; ++i) X[(wq * 64 + e * 16 + i) * 64 + lane] = o[e][i] * inv;
    }
    __syncthreads();
    if (map == 0) {
        float ss = 0.f;
#pragma unroll
        for (int e = 0; e < 4; ++e)
#pragma unroll
            for (int i = 0; i < 16; ++i) { const float v = o[e][i] * inv - lam * X[(wq * 64 + e * 16 + i) * 64 + lane]; o[e][i] = v; ss += v * v; }
        ss += __shfl_xor(ss, 32);
        const float r = rsqrtf(ss * (1.f / 128.f) + EPS) * oscale;
        bf16* MIX = (bf16*)(P.ws + WS_MIX) + (rowbase + q0 + r32) * D_MODEL + 1024 + h * 128;
        const float* sw = P.subln_w + l * 128;
#pragma unroll
        for (int e = 0; e < 4; ++e)
#pragma unroll
            for (int g = 0; g < 4; ++g) { const int ec = 32 * e + 8 * g + 4 * hh; const f32x4 w = *(const f32x4*)(sw + ec);
                v2u ov; ov.x = cvtpk(o[e][4 * g] * r * w.x, o[e][4 * g + 1] * r * w.y); ov.y = cvtpk(o[e][4 * g + 2] * r * w.z, o[e][4 * g + 3] * r * w.w);
                *(v2u*)(MIX + ec) = ov; }
    }
    __syncthreads();
}

constexpr int HP = 136, HTILE = 64 * HP * 2;
constexpr int KTP = 72;
__device__ __forceinline__ void lower_bound(const Params& P, int l, int dir, int col, float& lbm, float& oml) {
    const float* lg = P.lb_logits + (size_t)dir * DEPTH * 1024 + col;
    const float a0 = lg[0], a1 = lg[1024], a2 = lg[2048], a3 = lg[3072];
    const float mx = fmaxf(fmaxf(a0, a1), fmaxf(a2, a3));
    const float e0 = __expf(a0 - mx), e1 = __expf(a1 - mx), e2 = __expf(a2 - mx), e3 = __expf(a3 - mx);
    const float inv = 1.f / (e0 + e1 + e2 + e3);
    float lb = 0.f;
    if (l >= 1) lb += e1 * inv; if (l >= 2) lb += e2 * inv; if (l >= 3) lb += e3 * inv;
    lb = fminf(fmaxf(lb, 0.f), 1.0f - 1e-6f);
    lbm = fmaxf(lb, 1e-30f); oml = 1.f - lb;
}
__device__ __forceinline__ void hg_local_scan(const LAS unsigned short* zp, float lbm, float oml, int dir, float (&lf)[32], float (&kk)[32]) {
#pragma unroll
    for (int i = 0; i < 32; ++i) { const float z = bf2f(zp[i * HP]); const float sg = __builtin_amdgcn_rcpf(1.f + __expf(-z)); const float f = lbm + oml * sg; lf[i] = __logf(f); kk[i] = 1.f - f; }
    if (dir == 0) {
#pragma unroll
        for (int i = 1; i < 32; ++i) lf[i] += lf[i - 1];
    } else {
#pragma unroll
        for (int i = 30; i >= 0; --i) lf[i] += lf[i + 1];
    }
}
__device__ __forceinline__ void hg_load_tile(const bf16* PROJ, size_t row0, int col0, LAS unsigned char* dst, int tid) {
#pragma unroll
    for (int i = 0; i < 2; ++i) { const int p = tid + 512 * i, row = p >> 4, c = p & 15;
        *(LAS v4u*)(dst + row * (HP * 2) + c * 16) = *(const v4u*)(PROJ + (row0 + row) * WIN + col0 + c * 8); }
}
__device__ __forceinline__ void hg1_unit(const Params& P, int l, int bh, int c, LAS unsigned char* lds) {
    int tid_o = threadIdx.x; asm volatile("" : "+v"(tid_o));
    const int tid = tid_o, lane = tid & 63, r32 = lane & 31, hh = lane >> 5;
    const int wid = __builtin_amdgcn_readfirstlane(tid >> 6);
    const int b = bh >> 3, h = bh & 7;
    const size_t row0 = (size_t)b * SEQ + 64 * c;
    const bf16* PROJ = (const bf16*)(P.ws + WS_PROJ);
    LAS unsigned char* sV = lds; LAS unsigned char* sKT = lds + HTILE;
    LAS unsigned char* sZ = lds + HTILE + 2 * 128 * KTP * 2;
    hg_load_tile(PROJ, row0, C_HI + h * 128, sV, tid);
    hg_load_tile(PROJ, row0, C_HF + h * 128, sZ, tid);
    hg_load_tile(PROJ, row0, C_HB + h * 128, sZ + HTILE, tid);
    __syncthreads();
    {
        const int dir = tid >> 8, d = (tid >> 1) & 127, half = tid & 1;
        float lbm, oml; lower_bound(P, l, dir, h * 128 + d, lbm, oml);
        float lf[32], kk[32];
        hg_local_scan((const LAS unsigned short*)(sZ + dir * HTILE) + (32 * half) * HP + d, lbm, oml, dir, lf, kk);
        const float tot = dir ? lf[0] : lf[31];
        const float other = __shfl_xor(tot, 1);
        const bool far = dir ? (half == 0) : (half == 1);
        const float alast = tot + other, addfull = far ? other : 0.f;
        LAS unsigned char* dst = sKT + ((dir * 128 + d) * KTP + 32 * half) * 2;
#pragma unroll
        for (int g = 0; g < 4; ++g) { float kv[8];
#pragma unroll
            for (int j = 0; j < 8; ++j) kv[j] = kk[8 * g + j] * __expf(alast - (lf[8 * g + j] + addfull));
            v4u o; o.x = cvtpk(kv[0], kv[1]); o.y = cvtpk(kv[2], kv[3]); o.z = cvtpk(kv[4], kv[5]); o.w = cvtpk(kv[6], kv[7]);
            *(LAS v4u*)(dst + 16 * g) = o; }
        if (half == 0) ((float*)(P.ws + WS_DEC))[((size_t)(dir * 32 + bh) * 64 + c) * 128 + d] = __expf(alast);
    }
    __syncthreads();
    {
        const int dir = wid >> 2, db = wid & 3;
        bf16x8 af[4];
#pragma unroll
        for (int ks = 0; ks < 4; ++ks) af[ks] = *(const LAS bf16x8*)(sKT + ((dir * 128 + 32 * db + r32) * KTP + 16 * ks + 8 * hh) * 2);
        __syncthreads();
        const int vlane = ((lane & 15) >> 2) * (HP * 2) + (16 * ((lane >> 4) & 1) + 4 * (lane & 3)) * 2;
#pragma unroll
        for (int eb = 0; eb < 4; ++eb) {
            f32x16 acc;
#pragma unroll
            for (int i = 0; i < 16; ++i) acc[i] = 0.f;
#pragma unroll
            for (int ks = 0; ks < 4; ++ks) {
                const LAS unsigned char* a = sV + (16 * ks + 8 * hh) * (HP * 2) + 64 * eb + vlane;
                const s16x4 lo = vtr(a), hi = vtr(a + 4 * (HP * 2));
                const bf16x8 vf = __builtin_shufflevector(lo, hi, 0, 1, 2, 3, 4, 5, 6, 7);
                acc = MFMA32(af[ks], vf, acc);
            }
            LAS unsigned char* dst = sKT + ((dir * 128 + 32 * eb + r32) * HP + 32 * db + 4 * hh) * 2;
#pragma unroll
            for (int g = 0; g < 4; ++g) { v2u ov; ov.x = cvtpk(acc[4 * g], acc[4 * g + 1]); ov.y = cvtpk(acc[4 * g + 2], acc[4 * g + 3]); *(LAS v2u*)(dst + 16 * g) = ov; }
        }
    }
    __syncthreads();
    {
        bf16* ST = (bf16*)(P.ws + WS_ST);
#pragma unroll
        for (int i = 0; i < 8; ++i) { const int p = tid + 512 * i, dirp = p >> 11, rem = p & 2047, e = rem >> 4, c16 = rem & 15;
            const v4u v = *(const LAS v4u*)(sKT + ((dirp * 128 + e) * HP) * 2 + c16 * 16);
            *(v4u*)(ST + ((size_t)(dirp * 32 + bh) * 64 + c) * 16384 + e * 128 + c16 * 8) = v; }
    }
    __syncthreads();
}
template <int STEP> __device__ __forceinline__ void hg2_chain(const bf16* __restrict__ u0, bf16* __restrict__ s0, const LAS float* dec0) {
    float S[8];
#pragma unroll
    for (int j = 0; j < 8; ++j) S[j] = 0.f;
    for (int k0 = 0; k0 < 64; k0 += 8) {
        v4u u[8];
#pragma unroll
        for (int k = 0; k < 8; ++k) { const long c = (long)STEP * (k0 + k); u[k] = *(const v4u*)(u0 + c * 16384); }
#pragma unroll
        for (int k = 0; k < 8; ++k) { const int c = STEP * (k0 + k);
            const f32x4 d0 = *(const LAS f32x4*)(dec0 + c * 128), d1 = *(const LAS f32x4*)(dec0 + c * 128 + 4);
            v4u o; o.x = cvtpk(S[0], S[1]); o.y = cvtpk(S[2], S[3]); o.z = cvtpk(S[4], S[5]); o.w = cvtpk(S[6], S[7]);
            *(v4u*)(s0 + (long)c * 16384) = o;
            S[0] = d0.x * S[0] + bflo(u[k].x); S[1] = d0.y * S[1] + bfhi(u[k].x); S[2] = d0.z * S[2] + bflo(u[k].y); S[3] = d0.w * S[3] + bfhi(u[k].y);
            S[4] = d1.x * S[4] + bflo(u[k].z); S[5] = d1.y * S[5] + bfhi(u[k].z); S[6] = d1.z * S[6] + bflo(u[k].w); S[7] = d1.w * S[7] + bfhi(u[k].w); }
    }
}
__device__ __forceinline__ void hg2_scan(const Params& P, int bxi, int G, int tid, LAS unsigned char* lds) {
    LAS float* sdec = (LAS float*)lds;
    for (int wi = bxi; wi < 256; wi += G) {
        const int stream = wi >> 2, v16 = (wi & 3) * 512 + tid, dir = stream >> 5;
        { const f32x4* src = (const f32x4*)((const float*)(P.ws + WS_DEC) + (size_t)stream * 64 * 128);
#pragma unroll
          for (int i = 0; i < 4; ++i) ((LAS f32x4*)sdec)[tid + 512 * i] = src[tid + 512 * i]; }
        __syncthreads();
        const size_t eo = (size_t)stream * 64 * 16384 + v16 * 8;
        const bf16* ub = (const bf16*)(P.ws + WS_ST) + eo; bf16* sb = (bf16*)(P.ws + WS_ST2) + eo;
        const LAS float* dec = sdec + (v16 & 15) * 8;
        if (dir == 0) hg2_chain<1>(ub, sb, dec);
        else hg2_chain<-1>(ub + (size_t)63 * 16384, sb + (size_t)63 * 16384, dec + 63 * 128);
        __syncthreads();
    }
}
__device__ __forceinline__ void hg3_load_tiles(const Params& P, int bh, int c, int tid, v4u (&tl)[4][2]) {
    const bf16* PROJ = (const bf16*)(P.ws + WS_PROJ);
    const int b = bh >> 3, h = bh & 7; const size_t row0 = (size_t)b * SEQ + 64 * c;
    const int cols[4] = {C_HI, C_HF, C_HB, C_HQ};
#pragma unroll
    for (int q = 0; q < 4; ++q)
#pragma unroll
        for (int i = 0; i < 2; ++i) { const int p = tid + 512 * i, row = p >> 4, cc = p & 15; tl[q][i] = *(const v4u*)(PROJ + (row0 + row) * WIN + cols[q] + h * 128 + cc * 8); }
}
__device__ __forceinline__ void hg3_unit(const Params& P, int l, int bh, int c, int nbh, int nc, v4u (&tl)[4][2], LAS unsigned char* lds) {
    int tid_o = threadIdx.x; asm volatile("" : "+v"(tid_o));
    const int tid = tid_o, lane = tid & 63, r32 = lane & 31, hh = lane >> 5;
    const int wid = __builtin_amdgcn_readfirstlane(tid >> 6);
    const int b = bh >> 3, h = bh & 7;
    const size_t row0 = (size_t)b * SEQ + 64 * c;
    const bf16* PROJ = (const bf16*)(P.ws + WS_PROJ);
    LAS unsigned char* sV = lds;
    LAS unsigned char* sQi = lds + HTILE;
    LAS unsigned char* sKm = lds + 3 * HTILE;
    LAS unsigned char* sQm = lds + 5 * HTILE;
    LAS unsigned char* sSc = lds + 7 * HTILE;
    v4u gq0, gq1;
    { const bf16* gp = PROJ + (row0 + (tid >> 3)) * WIN + C_HG + h * 128 + (tid & 7) * 16; gq0 = *(const v4u*)gp; gq1 = *(const v4u*)(gp + 8); }
    { LAS unsigned char* dsts[4] = {sV, sQm, sQm + HTILE, sSc};
#pragma unroll
      for (int q = 0; q < 4; ++q)
#pragma unroll
        for (int i = 0; i < 2; ++i) { const int p = tid + 512 * i, row = p >> 4, cc = p & 15; *(LAS v4u*)(dsts[q] + row * (HP * 2) + cc * 16) = tl[q][i]; } }
    if (nbh >= 0) hg3_load_tiles(P, nbh, nc, tid, tl);
    __syncthreads();
    {
        const int dir = tid >> 8, d = (tid >> 1) & 127, half = tid & 1;
        float lbm, oml; lower_bound(P, l, dir, h * 128 + d, lbm, oml);
        float lf[32], kk[32];
        hg_local_scan((const LAS unsigned short*)(sQm + dir * HTILE) + (32 * half) * HP + d, lbm, oml, dir, lf, kk);
        const LAS unsigned short* qp = (const LAS unsigned short*)sSc + (32 * half) * HP + d;
        const float tot = dir ? lf[0] : lf[31];
        const float other = __shfl_xor(tot, 1);
        const bool far = dir ? (half == 0) : (half == 1);
        const float addfull = far ? other : 0.f, subrel = far ? 0.f : tot;
        const int o0 = dir * HTILE + ((32 * half) * HP + d) * 2;
        const float cfull = __expf(addfull + subrel);
#pragma unroll
        for (int i = 0; i < 32; ++i) {
            const float qv = bf2f(qp[i * HP]);
            const float arel = lf[i] - subrel;
            const float em = __expf(arel), qm = qv * em;
            const unsigned w0 = cvtpk(qm * cfull, qm), w1 = cvtpk(kk[i] * __expf(-arel), 0.f);
            *(LAS unsigned short*)(sQi + o0 + i * HP * 2) = (unsigned short)(w0 & 0xffffu);
            *(LAS unsigned short*)(sQm + o0 + i * HP * 2) = (unsigned short)(w0 >> 16);
            *(LAS unsigned short*)(sKm + o0 + i * HP * 2) = (unsigned short)(w1 & 0xffffu);
        }
    }
    __syncthreads();
    bf16x8 spf[2][8];
    { const int eb_ = wid & 3;
#pragma unroll
      for (int dir = 0; dir < 2; ++dir) { const bf16* Sp = (const bf16*)(P.ws + WS_ST2) + ((size_t)(dir * 32 + bh) * 64 + c) * 16384 + (size_t)(32 * eb_ + r32) * 128 + 8 * hh;
#pragma unroll
        for (int ks = 0; ks < 8; ++ks) spf[dir][ks] = *(const bf16x8*)(Sp + 16 * ks); } }
    {
        const int dir = wid >> 2, I = (wid >> 1) & 1, J = wid & 1;
        const bool dead = dir ? (I == 1 && J == 0) : (I == 0 && J == 1);
        f32x16 acc;
#pragma unroll
        for (int i = 0; i < 16; ++i) acc[i] = 0.f;
        if (!dead) {
            const LAS unsigned char* ka = sKm + dir * HTILE + ((32 * J + r32) * HP + 8 * hh) * 2;
            const LAS unsigned char* qa = sQm + dir * HTILE + ((32 * I + r32) * HP + 8 * hh) * 2;
#pragma unroll
            for (int ks = 0; ks < 8; ++ks) acc = MFMA32(*(const LAS bf16x8*)(ka + 32 * ks), *(const LAS bf16x8*)(qa + 32 * ks), acc);
        }
        const int tt = 32 * I + r32;
        LAS unsigned char* dst = sSc + ((dir * 64 + tt) * KTP + 32 * J + 4 * hh) * 2;
#pragma unroll
        for (int g = 0; g < 4; ++g) { float v[4];
#pragma unroll
            for (int j = 0; j < 4; ++j) { const int s = 32 * J + 8 * g + 4 * hh + j; const bool keep = dir ? (s >= tt) : (s <= tt); v[j] = keep ? acc[4 * g + j] : 0.f; }
            v2u ov; ov.x = cvtpk(v[0], v[1]); ov.y = cvtpk(v[2], v[3]); *(LAS v2u*)(dst + 16 * g) = ov; }
    }
    __syncthreads();
    {
        const int tb = wid >> 2, eb = wid & 3;
        f32x16 acc;
#pragma unroll
        for (int i = 0; i < 16; ++i) acc[i] = 0.f;
        const int vlane = ((lane & 15) >> 2) * (HP * 2) + (16 * ((lane >> 4) & 1) + 4 * (lane & 3)) * 2;
#pragma unroll
        for (int dir = 0; dir < 2; ++dir) {
            const LAS unsigned char* qa = sQi + dir * HTILE + ((32 * tb + r32) * HP + 8 * hh) * 2;
#pragma unroll
            for (int ks = 0; ks < 8; ++ks) acc = MFMA32(*(const LAS bf16x8*)(qa + 32 * ks), spf[dir][ks], acc);
            const LAS unsigned char* sa = sSc + ((dir * 64 + 32 * tb + r32) * KTP + 8 * hh) * 2;
#pragma unroll
            for (int ks = 0; ks < 4; ++ks) {
                const LAS unsigned char* a = sV + (16 * ks + 8 * hh) * (HP * 2) + 64 * eb + vlane;
                const s16x4 lo = vtr(a), hi = vtr(a + 4 * (HP * 2));
                const bf16x8 vf = __builtin_shufflevector(lo, hi, 0, 1, 2, 3, 4, 5, 6, 7);
                acc = MFMA32(*(const LAS bf16x8*)(sa + 32 * ks), vf, acc);
            }
        }
        LAS float* sO = (LAS float*)sQm;
#pragma unroll
        for (int i = 0; i < 16; ++i) sO[(32 * tb + (i & 3) + 8 * (i >> 2) + 4 * hh) * 132 + 32 * eb + r32] = acc[i];
    }
    __syncthreads();
    {
        const int t = tid >> 3, e0 = (tid & 7) * 16;
        const LAS float* so = (const LAS float*)sQm + t * 132 + e0;
        float v[16]; float ss = 0.f;
#pragma unroll
        for (int j = 0; j < 16; ++j) { v[j] = so[j]; ss += v[j] * v[j]; }
        ss += __shfl_xor(ss, 1); ss += __shfl_xor(ss, 2); ss += __shfl_xor(ss, 4);
        const float r = rsqrtf(ss * (1.f / 128.f) + EPS);
        const v4u g0 = gq0, g1 = gq1;
        const float gv[16] = {bflo(g0.x), bfhi(g0.x), bflo(g0.y), bfhi(g0.y), bflo(g0.z), bfhi(g0.z), bflo(g0.w), bfhi(g0.w),
                              bflo(g1.x), bfhi(g1.x), bflo(g1.y), bfhi(g1.y), bflo(g1.z), bfhi(g1.z), bflo(g1.w), bfhi(g1.w)};
        const float* ow = P.onorm_w + l * 128 + e0;
        float y[16];
#pragma unroll
        for (int j = 0; j < 16; ++j) { const float g = gv[j]; y[j] = v[j] * r * ow[j] * (g * __builtin_amdgcn_rcpf(1.f + __expf(-g))); }
        bf16* mp = (bf16*)(P.ws + WS_MIX) + (row0 + t) * D_MODEL + h * 128 + e0;
        v4u o0, o1;
        o0.x = cvtpk(y[0], y[1]); o0.y = cvtpk(y[2], y[3]); o0.z = cvtpk(y[4], y[5]); o0.w = cvtpk(y[6], y[7]);
        o1.x = cvtpk(y[8], y[9]); o1.y = cvtpk(y[10], y[11]); o1.z = cvtpk(y[12], y[13]); o1.w = cvtpk(y[14], y[15]);
        *(v4u*)mp = o0; *(v4u*)(mp + 8) = o1;
    }
    __syncthreads();
}

#define XB_TMO      128
#define XB_XCNT(j)  (256  + 64 * (j))
#define XB_XSUB(j)  (1280 + 64 * (j))
#define XB_XGEN(j)  (2304 + 64 * (j))
#define XB_TOP      3328
#define XB_TOPGEN   3392
#define XCD_BAR_WORDS 3456
#define XB_SPIN_CAP (1u << 24)
__device__ __forceinline__ unsigned xb_ld(unsigned* p)              { return __hip_atomic_load(p, __ATOMIC_RELAXED, __HIP_MEMORY_SCOPE_AGENT); }
__device__ __forceinline__ unsigned xb_add(unsigned* p, unsigned v) { return __hip_atomic_fetch_add(p, v, __ATOMIC_RELAXED, __HIP_MEMORY_SCOPE_AGENT); }
__device__ __forceinline__ unsigned xb_xcc_id() { return (unsigned)__builtin_amdgcn_s_getreg((3 << 11) | 20) & 0xFu; }
#define XB_SPIN(cond, bar) do { unsigned _sp = 0; while (cond) { __builtin_amdgcn_s_sleep(1); \
    if ((++_sp & 255u) == 0u) { if (xb_ld(&(bar)[XB_TMO])) break; if (_sp > XB_SPIN_CAP) { atomicAdd(&(bar)[XB_TMO], 1u); break; } } } } while (0)
struct XcdBarrier { unsigned* bar; unsigned x; volatile LAS unsigned* st; };
__device__ __forceinline__ XcdBarrier xcd_barrier_post(unsigned* bar, volatile LAS unsigned* st) {
    XcdBarrier b; b.bar = bar; b.x = xb_xcc_id(); b.st = st;
    if (threadIdx.x == 0) (void)xb_add(&bar[XB_XCNT(b.x)], 1u);
    return b;
}
__device__ __forceinline__ void xcd_barrier_complete(unsigned* bar, unsigned x, unsigned& nloc, unsigned& nx) {
    const unsigned G = gridDim.x * gridDim.y * gridDim.z;
    unsigned sum, cnt, mine, sp = 0u;
    for (;;) {
        sum = 0u; cnt = 0u; mine = 0u;
#pragma unroll
        for (unsigned j = 0; j < 16; ++j) { const unsigned c = xb_ld(&bar[XB_XCNT(j)]); sum += c; cnt += (c > 0u) ? 1u : 0u; mine = (j == x) ? c : mine; }
        if (sum == G) break;
        __builtin_amdgcn_s_sleep(1);
        if ((++sp & 255u) == 0u) { if (xb_ld(&bar[XB_TMO])) break; if (sp > XB_SPIN_CAP) { atomicAdd(&bar[XB_TMO], 1u); break; } }
    }
    nloc = mine > 0u ? mine : 1u; nx = cnt > 0u ? cnt : 1u;
}
__device__ __forceinline__ void xcd_barrier(const XcdBarrier& b) {
    asm volatile("s_waitcnt vmcnt(0)" ::: "memory");
    __syncthreads();
    if (threadIdx.x == 0) {
        unsigned* bar = b.bar;
        __builtin_amdgcn_s_waitcnt(0);
        unsigned nloc = b.st[0], nx = b.st[1];
        if (nloc == 0u) { xcd_barrier_complete(bar, b.x, nloc, nx); b.st[0] = nloc; b.st[1] = nx; }
        const unsigned old = xb_add(&bar[XB_XSUB(b.x)], 1u);
        const unsigned gen = old / nloc;
        if (old + 1u == (gen + 1u) * nloc) {
            __builtin_amdgcn_fence(__ATOMIC_RELEASE, "agent");
            asm volatile("s_waitcnt vmcnt(0)" ::: "memory");
            const unsigned og = xb_add(&bar[XB_TOP], 1u);
            const unsigned tg = og / nx;
            if (og + 1u == (tg + 1u) * nx) xb_add(&bar[XB_TOPGEN], 1u);
            else XB_SPIN(xb_ld(&bar[XB_TOPGEN]) == tg, bar);
            __builtin_amdgcn_fence(__ATOMIC_ACQUIRE, "agent");
            xb_add(&bar[XB_XGEN(b.x)], 1u);
            asm volatile("s_waitcnt vmcnt(0)" ::: "memory");
        } else {
            XB_SPIN(xb_ld(&bar[XB_XGEN(b.x)]) == gen, bar);
            __builtin_amdgcn_fence(__ATOMIC_ACQUIRE, "agent");
            asm volatile("s_waitcnt vmcnt(0)" ::: "memory");
        }
    }
    __syncthreads();
}

__global__ void __launch_bounds__(NTHR, 2) hybrid_fwd(Params P) {
    extern __shared__ __attribute__((aligned(16))) unsigned char lds_raw[];
    cg::grid_group grid = cg::this_grid();
    LAS unsigned char* lds = (LAS unsigned char*)lds_raw;
    const int G = gridDim.x, bx = blockIdx.x, ngw = G * NWAVES;
    volatile LAS unsigned* xst = (volatile LAS unsigned*)(lds + LDS_BYTES - 64);
    if (threadIdx.x < 2) xst[threadIdx.x] = 0u;
    __syncthreads();
    const XcdBarrier xbar = xcd_barrier_post((unsigned*)P.ws, xst);
#define GRID_BAR() xcd_barrier(xbar)
#define TIDS() int tid = threadIdx.x; asm volatile("" : "+v"(tid)); const int lane = tid & 63, wave = __builtin_amdgcn_readfirstlane(tid >> 6), gw = bx * NWAVES + wave; (void)lane; (void)gw
    float* RTmix = (float*)(P.ws + 131072); float* RTffn = (float*)(P.ws + 262144);
    float* SSPmix = (float*)(P.ws + WS_SSP); float* SSPffn = (float*)(P.ws + WS_SSP + 2 * MiB);
    bf16* H = (bf16*)(P.ws + WS_H); bf16* PROJ = (bf16*)(P.ws + WS_PROJ); bf16* MIX = (bf16*)(P.ws + WS_MIX); bf16* U = (bf16*)(P.ws + WS_PROJ);
    const bf16* WTin = (const bf16*)(P.ws + WS_WIN); const bf16* WTout = (const bf16*)(P.ws + WS_WOUT); const bf16* WTgu = (const bf16*)(P.ws + WS_WGU); const bf16* WTdn = (const bf16*)(P.ws + WS_WDN);

#ifdef PROBE_PHASE
    unsigned psel = 0u, ptot = 0u; unsigned pt0 = (unsigned)__builtin_amdgcn_s_memrealtime();
#define PSTAMP(k) do { const unsigned t1_ = (unsigned)__builtin_amdgcn_s_memrealtime(); const unsigned d_ = t1_ - pt0; ptot += d_; if ((PROBE_PHASE >> (k)) & 1) psel += d_; pt0 = t1_; } while (0)
#else
#define PSTAMP(k) do {} while (0)
#endif
    for (int l = 0; l < DEPTH; ++l) {
        const float* xin = (l == 0) ? P.x : P.out;
#ifndef SKIP_P0
        { TIDS(); convert_weights(P, l, lds, gw, ngw, wave, lane);
          if (l == 0) x_to_bf16_rows(P.x, H, RTmix, gw, ngw, lane); else rstd_rows(SSPmix, RTmix, bx * NTHR + tid, G * NTHR); }
#endif
        if (l == 0) grid.sync(); else GRID_BAR();
        PSTAMP(0);
#ifndef SKIP_P1
        { int tq = threadIdx.x; asm volatile("" : "+v"(tq));
          if (tq < 128) ((LAS float*)(lds + pg8::RS_OFF + 2048))[tq] = (tq < 64) ? P.qn_w[l * 64 + tq] * (0.125f * LOG2E) : P.kn_w[l * 64 + tq - 64];
          __syncthreads(); }
        { pg8::Gemm g{H, WTin, MTOK, WIN, D_MODEL}; pg8::RowScaleOrder S; S.init(MTOK, WIN, G, bx); S.rtab = RTmix; S.lds0 = lds; S.k = 0;
          pg8::EpiBf16Scale E{PROJ, WIN, lds, 0};
          pg8::gemm_phase<pg8::EpiBf16Scale, pg8::RowScaleOrder, true, true>(lds, g, S, E); }
#endif

        GRID_BAR();
        PSTAMP(1);
        {
            TIDS();
            const float* lp = P.da_lambda + l * 256;
            const float sa = wave_sum(lp[lane] * lp[64 + lane]), sb = wave_sum(lp[128 + lane] * lp[192 + lane]);
            const float lam_init = 0.8f - 0.6f * expf(-0.3f * (float)l);
            const float lam = expf(sa) - expf(sb) + lam_init;
            float mq = fabsf(P.qn_w[l * 64 + lane]), mk = fabsf(P.kn_w[l * 64 + lane]);
#pragma unroll
            for (int o_ = 1; o_ < 64; o_ <<= 1) { mq = fmaxf(mq, __shfl_xor(mq, o_)); mk = fmaxf(mk, __shfl_xor(mk, o_)); }
            const float zbound = 2.04f * 8.f * mq * mk + 104.5f;
            unsigned* qctr = (unsigned*)P.ws + 4096 + 64 * l;
            volatile LAS unsigned* qslot = (volatile LAS unsigned*)(lds + LDS_BYTES - 48);
            if (tid == 0) *qslot = __hip_atomic_fetch_add(qctr, 1u, __ATOMIC_RELAXED, __HIP_MEMORY_SCOPE_AGENT);
            __syncthreads();
            int it = __builtin_amdgcn_readfirstlane((int)*qslot);
            __syncthreads();
            while (it < 3072) {
                unsigned pre = 0u;
                if (tid == 0) pre = __hip_atomic_fetch_add(qctr, 1u, __ATOMIC_RELAXED, __HIP_MEMORY_SCOPE_AGENT);
                if (it < 1024) { const int h = 7 - (it >> 7), j = it & 127; attn_unit(P, l, j >> 5, h, j & 31, lam, 1.f - lam_init, zbound, lds); }
                else { const int u = it - 1024; hg1_unit(P, l, u >> 6, u & 63, lds); }
                if (tid == 0) *qslot = pre;
                __syncthreads();
                it = __builtin_amdgcn_readfirstlane((int)*qslot);
                __syncthreads();
            }
        }
        GRID_BAR();
        PSTAMP(3);
#ifndef SKIP_H2
        { TIDS(); hg2_scan(P, bx, G, tid, lds); }
#endif
        GRID_BAR();
        PSTAMP(4);
#ifndef SKIP_H3
        { int tq = threadIdx.x; asm volatile("" : "+v"(tq));
          v4u tl[4][2];
          { const int u0 = (bx < 2048) ? bx : 2047; hg3_load_tiles(P, u0 >> 6, u0 & 63, tq, tl); }
          for (int u = bx; u < 2048; u += G) { const int un = u + G; hg3_unit(P, l, u >> 6, u & 63, (un < 2048) ? (un >> 6) : -1, un & 63, tl, lds); } }
#endif
        GRID_BAR();
        PSTAMP(5);
#ifndef SKIP_P5
        { pg8::Gemm g{MIX, WTout, MTOK, D_MODEL, D_MODEL}; pg8::StaticOrder S; S.init(MTOK, D_MODEL, G, bx);
          pg8::EpiResF32 E{nullptr, D_MODEL, H, SSPffn};
          pg8::gemm_phase<pg8::EpiResF32, pg8::StaticOrder, true, true>(lds, g, S, E); }
#endif

        GRID_BAR();
        PSTAMP(6);
#ifndef SKIP_P6
        { TIDS(); rstd_rows(SSPffn, RTffn, bx * NTHR + tid, G * NTHR); }
#endif

        GRID_BAR();
        PSTAMP(7);
#ifndef SKIP_P7
        { pg8::Gemm g{H, WTgu, MTOK, 2 * DFF, D_MODEL}; pg8::RowScaleOrder S; S.init(MTOK, 2 * DFF, G, bx); S.rtab = RTffn; S.lds0 = lds; S.k = 0;
          pg8::EpiSwiGLU E{U, DFF, lds, 0};
          pg8::gemm_phase<pg8::EpiSwiGLU, pg8::RowScaleOrder, true, true>(lds, g, S, E); }
#endif

        GRID_BAR();
        PSTAMP(8);
#ifndef SKIP_P8
        { pg8::Gemm g{U, WTdn, MTOK, D_MODEL, DFF}; pg8::StaticOrder S; S.init(MTOK, D_MODEL, G, bx);
          pg8::EpiResF32 E{(l + 1 < DEPTH) ? nullptr : P.out, D_MODEL, H, SSPmix};
          pg8::gemm_phase<pg8::EpiResF32, pg8::StaticOrder, true, true>(lds, g, S, E); }
#endif

        GRID_BAR();
        PSTAMP(9);
    }
#ifdef PROBE_PHASE
    if (bx == 0 && threadIdx.x == 0) P.out[0] += 0.35f + 0.7f * ((float)psel / (float)ptot);
#endif
}

extern "C" void kernel_launch(void* const* d_in, const int* in_sizes, int n_in, void* d_out, int out_size, void* d_ws, size_t ws_size, hipStream_t stream) {
    static int grid_blocks = 0;
    if (grid_blocks == 0) {
        if (n_in != 14 || ws_size < WS_END) { fprintf(stderr, "kernel_launch: unexpected n_in %d or ws_size %zu (need %zu)\n", n_in, ws_size, (size_t)WS_END); grid_blocks = -1; return; }
        int dev = 0, cus = 0, per_cu = 0;
        hipGetDevice(&dev);
        hipDeviceGetAttribute(&cus, hipDeviceAttributeMultiprocessorCount, dev);
        if (hipFuncSetAttribute((const void*)hybrid_fwd, hipFuncAttributeMaxDynamicSharedMemorySize, LDS_BYTES) != hipSuccess) fprintf(stderr, "kernel_launch: hipFuncSetAttribute failed\n");
        if (hipOccupancyMaxActiveBlocksPerMultiprocessor(&per_cu, (const void*)hybrid_fwd, NTHR, LDS_BYTES) != hipSuccess || per_cu < 1) { fprintf(stderr, "kernel_launch: occupancy query gave %d\n", per_cu); per_cu = 1; }
        (void)hipGetLastError();
        grid_blocks = cus * per_cu;
    }
    if (grid_blocks < 0) return;
    Params p{};
    p.x = (const float*)d_in[0]; p.norm_mix_w = (const float*)d_in[1]; p.w_in = (const float*)d_in[2]; p.lb_logits = (const float*)d_in[3]; p.onorm_w = (const float*)d_in[4];
    p.qn_w = (const float*)d_in[5]; p.kn_w = (const float*)d_in[6]; p.da_lambda = (const float*)d_in[7]; p.subln_w = (const float*)d_in[8]; p.w_out = (const float*)d_in[9];
    p.norm_ffn_w = (const float*)d_in[10]; p.w_gate = (const float*)d_in[11]; p.w_up = (const float*)d_in[12]; p.w_down = (const float*)d_in[13];
    p.out = (float*)d_out; p.ws = (unsigned char*)d_ws;
    if (hipMemsetAsync(d_ws, 0, 65536, stream) != hipSuccess) { fprintf(stderr, "kernel_launch: memset of barrier words failed\n"); return; }
    void* args[] = {&p};
    hipError_t e = hipLaunchCooperativeKernel((const void*)hybrid_fwd, dim3(grid_blocks), dim3(NTHR), args, LDS_BYTES, stream);
    if (e != hipSuccess) fprintf(stderr, "kernel_launch: cooperative launch failed: %s (grid %d)\n", hipGetErrorString(e), grid_blocks);
}
```
